# Optimizing an MI355X kernel written in HIP

```python
import math
import jax, jax.numpy as jnp
from jax import lax
import numpy as np

D_MODEL = 4096
BATCH = 1
SEQ = 8192
DEPTH = 1

N_META = 16
BLOCK = 128
PAD = (-N_META) % BLOCK
HEAD_DIM = 128
DIFF_V_DIM = 2 * HEAD_DIM
DIFF_WIDTH = D_MODEL // 2
FOX_WIDTH = D_MODEL - DIFF_WIDTH
N_DIFF_HEADS = DIFF_WIDTH // DIFF_V_DIM
N_FOX_HEADS = FOX_WIDTH // HEAD_DIM
MIX_WIDTH = DIFF_WIDTH + FOX_WIDTH
D_FF = 256 * ((8 * D_MODEL // 3 + 255) // 256)
SPLIT_SIZES = (DIFF_WIDTH, DIFF_WIDTH, DIFF_WIDTH, FOX_WIDTH, FOX_WIDTH, FOX_WIDTH, N_FOX_HEADS)
IN_COLS = sum(SPLIT_SIZES)
RMS_EPS = 1e-6
SUBLN_EPS = 1e-5
NEG_INF = -1e30

kernel_name = 'hymba_diff_fox_macaron_alibi'


def rms_norm(x, g, eps=RMS_EPS):
    xf = x.astype(jnp.float32)
    y = xf * lax.rsqrt(jnp.mean(xf * xf, axis=-1, keepdims=True) + eps)
    return (y * g.astype(jnp.float32)).astype(x.dtype)


def swiglu(h, w_gate, w_up, w_down):
    return (jax.nn.silu(h @ w_gate) * (h @ w_up)) @ w_down


def alibi_slopes(n):
    return 2.0 ** (-8.0 * jnp.arange(1, n + 1, dtype=jnp.float32) / n)


def hybrid_mixer(h, w_in, b_forget, lambda_q1, lambda_k1, lambda_q2, lambda_k2,
                 subln_gain, w_out, lambda_init):
    B, L, _ = h.shape
    proj = h @ w_in
    proj = jnp.pad(proj, ((0, 0), (PAD, 0), (0, 0)))
    Lp = L + PAD
    n_blocks = Lp // BLOCK
    q_d, k_d, v_d, q_f, k_f, v_f, f_logit = jnp.split(
        proj, np.cumsum(SPLIT_SIZES)[:-1].tolist(), axis=-1)
    q_d = q_d.reshape(B, Lp, N_DIFF_HEADS, 2, HEAD_DIM)
    k_d = k_d.reshape(B, Lp, N_DIFF_HEADS, 2, HEAD_DIM)
    v_d = v_d.reshape(B, Lp, N_DIFF_HEADS, DIFF_V_DIM)
    q_f = q_f.reshape(B, Lp, N_FOX_HEADS, HEAD_DIM)
    k_f = k_f.reshape(B, Lp, N_FOX_HEADS, HEAD_DIM)
    v_f = v_f.reshape(B, Lp, N_FOX_HEADS, HEAD_DIM)

    pos = jnp.arange(Lp)
    key_valid = pos >= PAD
    scale = HEAD_DIM ** -0.5

    log_f = jax.nn.log_sigmoid(f_logit.astype(jnp.float32) + b_forget.astype(jnp.float32))
    log_f = jnp.where(key_valid[None, :, None], log_f, 0.0)
    cum = jnp.swapaxes(jnp.cumsum(log_f, axis=1), 1, 2)

    lam = (jnp.exp(jnp.sum(lambda_q1.astype(jnp.float32) * lambda_k1.astype(jnp.float32)))
           - jnp.exp(jnp.sum(lambda_q2.astype(jnp.float32) * lambda_k2.astype(jnp.float32)))
           + lambda_init)
    slopes = alibi_slopes(N_DIFF_HEADS)

    def block(i):
        start = i * BLOCK
        qpos = start + jnp.arange(BLOCK)
        rel = (qpos[:, None] - pos[None, :]).astype(jnp.float32)
        mask = (rel >= 0) & key_valid[None, :]
        qd = lax.dynamic_slice_in_dim(q_d, start, BLOCK, axis=1)
        s = jnp.einsum('bqhcd,bkhcd->bhcqk', qd, k_d).astype(jnp.float32) * scale
        s = s - slopes[:, None, None, None] * rel
        p = jax.nn.softmax(jnp.where(mask, s, NEG_INF), axis=-1)
        a = (p[:, :, 0] - lam * p[:, :, 1]).astype(v_d.dtype)
        o_d = jnp.einsum('bhqk,bkhe->bqhe', a, v_d)
        qf = lax.dynamic_slice_in_dim(q_f, start, BLOCK, axis=1)
        cq = lax.dynamic_slice_in_dim(cum, start, BLOCK, axis=2)
        s = jnp.einsum('bqhd,bkhd->bhqk', qf, k_f).astype(jnp.float32) * scale
        s = s + cq[..., :, None] - cum[..., None, :]
        p = jax.nn.softmax(jnp.where(mask, s, NEG_INF), axis=-1)
        o_f = jnp.einsum('bhqk,bkhd->bqhd', p.astype(v_f.dtype), v_f)
        return o_d, o_f

    o_d, o_f = lax.map(block, jnp.arange(n_blocks))
    o_d = jnp.moveaxis(o_d, 0, 1).reshape(B, Lp, N_DIFF_HEADS, DIFF_V_DIM)[:, PAD:]
    o_f = jnp.moveaxis(o_f, 0, 1).reshape(B, Lp, N_FOX_HEADS, HEAD_DIM)[:, PAD:]
    o_d = rms_norm(o_d, subln_gain, SUBLN_EPS) * (1.0 - lambda_init)
    o = jnp.concatenate([o_d.reshape(B, L, DIFF_WIDTH), o_f.reshape(B, L, FOX_WIDTH)], axis=-1)
    return o @ w_out


def setup_inputs(seed: int = 0) -> dict:
    key = jax.random.key(seed)
    ks = jax.random.split(key, 20)
    f32 = jnp.float32
    n = lambda k, shape, s: jax.random.normal(k, shape, f32) * s
    gain = lambda k, shape: 1.0 + 0.02 * jax.random.normal(k, shape, f32)
    return {
        'x': jax.random.normal(ks[0], (BATCH, SEQ, D_MODEL), f32),
        'meta_tokens': n(ks[1], (N_META, D_MODEL), 1.0),
        'ffn1_norm': gain(ks[2], (DEPTH, D_MODEL)),
        'ffn1_w_gate': n(ks[3], (DEPTH, D_MODEL, D_FF), D_MODEL ** -0.5),
        'ffn1_w_up': n(ks[4], (DEPTH, D_MODEL, D_FF), D_MODEL ** -0.5),
        'ffn1_w_down': n(ks[5], (DEPTH, D_FF, D_MODEL), D_FF ** -0.5),
        'mix_norm': gain(ks[6], (DEPTH, D_MODEL)),
        'w_in': n(ks[7], (DEPTH, D_MODEL, IN_COLS), D_MODEL ** -0.5),
        'b_forget': n(ks[8], (DEPTH, N_FOX_HEADS), 0.5) + 1.0,
        'lambda_q1': n(ks[9], (DEPTH, HEAD_DIM), 0.1),
        'lambda_k1': n(ks[10], (DEPTH, HEAD_DIM), 0.1),
        'lambda_q2': n(ks[11], (DEPTH, HEAD_DIM), 0.1),
        'lambda_k2': n(ks[12], (DEPTH, HEAD_DIM), 0.1),
        'subln_gain': gain(ks[13], (DEPTH, DIFF_V_DIM)),
        'w_out': n(ks[14], (DEPTH, MIX_WIDTH, D_MODEL), MIX_WIDTH ** -0.5),
        'ffn2_norm': gain(ks[15], (DEPTH, D_MODEL)),
        'ffn2_w_gate': n(ks[16], (DEPTH, D_MODEL, D_FF), D_MODEL ** -0.5),
        'ffn2_w_up': n(ks[17], (DEPTH, D_MODEL, D_FF), D_MODEL ** -0.5),
        'ffn2_w_down': n(ks[18], (DEPTH, D_FF, D_MODEL), D_FF ** -0.5),
        'final_norm': gain(ks[19], (D_MODEL,)),
    }


def reference(x, meta_tokens, ffn1_norm, ffn1_w_gate, ffn1_w_up, ffn1_w_down,
              mix_norm, w_in, b_forget, lambda_q1, lambda_k1, lambda_q2, lambda_k2,
              subln_gain, w_out, ffn2_norm, ffn2_w_gate, ffn2_w_up, ffn2_w_down,
              final_norm):
    B = x.shape[0]
    meta = jnp.broadcast_to(meta_tokens[None].astype(x.dtype), (B, N_META, D_MODEL))
    h = jnp.concatenate([meta, x], axis=1)
    for l in range(DEPTH):
        lambda_init = 0.8 - 0.6 * math.exp(-0.3 * l)
        h = h + 0.5 * swiglu(rms_norm(h, ffn1_norm[l]), ffn1_w_gate[l], ffn1_w_up[l], ffn1_w_down[l])
        h = h + hybrid_mixer(rms_norm(h, mix_norm[l]), w_in[l], b_forget[l],
                             lambda_q1[l], lambda_k1[l], lambda_q2[l], lambda_k2[l],
                             subln_gain[l], w_out[l], lambda_init)
        h = h + 0.5 * swiglu(rms_norm(h, ffn2_norm[l]), ffn2_w_gate[l], ffn2_w_up[l], ffn2_w_down[l])
    return rms_norm(h, final_norm)[:, N_META:]
```

```cpp
#include <hip/hip_runtime.h>
#include <cstdio>
#include <cstdint>
#ifndef MK_N_LAUNCHES
#define MK_N_LAUNCHES 1
#endif
namespace pg8 {
#define PG8_LAS __attribute__((address_space(3)))
typedef unsigned short bf16_t;
typedef short bf16x8 __attribute__((ext_vector_type(8)));
typedef float f32x4 __attribute__((ext_vector_type(4)));
typedef unsigned u32x4 __attribute__((ext_vector_type(4)));
constexpr int BM = 256, BK = 64, HALF = 128, HTB = HALF * BK * 2  , STAGE_BYTES = 8 * HTB, NXCD = 8, WGM = 8;

__host__ __device__ __forceinline__ int lds_byte(int r, int c) { const int st = (r >> 4) * 2 + (c >> 5), rr = r & 15, cc = c & 31, ob = rr * 64 + cc * 2; return st * 1024 + (ob ^ (((ob >> 9) & 1) << 5)); }
__host__ __device__ __forceinline__ void stage_rc(int b, int& R, int& C) { const int st = b / 1024, sb = b % 1024, swz = sb ^ (((sb >> 9) & 1) << 5); R = (st >> 1) * 16 + swz / 64; C = (st & 1) * 32 + (swz % 64) / 2; }
__host__ __device__ __forceinline__ int perm32(int rho) { const int n = rho >> 4, i = rho & 15; return 8 * (i >> 2) + 4 * n + (i & 3); }

struct Unit { int pm, pn; };
struct Gemm { const bf16_t* A; const bf16_t* Bt; int M, N, K; };

struct StaticOrder {
    int nM, nN, nwg, G, c;
    __host__ __device__ void init(int M, int N, int G_, int c_) { nM = M / BM; nN = N / BM; nwg = nM * nN; G = G_; c = c_; }
    __host__ __device__ bool next(int i, Unit& u) const {
        const long L = (long)i * G + c; if (L >= nwg) return false;
        int wgid = (int)L; { const int q = nwg / NXCD, r = nwg % NXCD, xcd = wgid % NXCD, off = wgid / NXCD; wgid = (xcd < r ? xcd * (q + 1) : r * (q + 1) + (xcd - r) * q) + off; }
        const int nig = WGM * nN, gid = wgid / nig, fm = gid * WGM, gsz = (nM - fm) < WGM ? (nM - fm) : WGM;
        u.pm = fm + ((wgid % nig) % gsz); u.pn = (wgid % nig) / gsz; return true;
    }
    __device__ __forceinline__ void a_ready(const Unit&) const {}
    __device__ __forceinline__ void done(const Unit&) const {}
};

__device__ __forceinline__ unsigned cvt_pk_bf16(float lo, float hi) { unsigned r; asm volatile("v_cvt_pk_bf16_f32 %0, %1, %2" : "=v"(r) : "v"(lo), "v"(hi)); return r; }
__device__ __forceinline__ float silu_mul(float g, float u) { const float e = __builtin_amdgcn_exp2f(g * -1.4426950408889634f); return g * __builtin_amdgcn_rcpf(1.0f + e) * u; }

__device__ __forceinline__ float rstd_of(const unsigned long long* ss, int row, float eps) {
    const unsigned long long v = ss[row];
    return 1.0f / sqrtf((float)v * (1.0f / (16777216.0f * 4096.0f)) + eps);
}
__device__ __forceinline__ float rstd_from(unsigned long long v, float eps) { return 1.0f / sqrtf((float)v * (1.0f / (16777216.0f * 4096.0f)) + eps); }
struct EpiSwiGLU {
    static constexpr bool PERM = true, AFTER_DRAIN = false;
    bf16_t* O; int ldc; int row_off; const unsigned long long* ss;
    __device__ __forceinline__ void operator()(const f32x4 (&acc)[2][2][4][2], const Unit& u, int wr, int wc, int fr, int fq) const {
        const int row0 = row_off + u.pm * BM + wr * 64 + fr, col0 = u.pn * HALF + wc * 32 + 8 * fq;
        unsigned long long sv[2][4];
#pragma unroll
        for (int ai = 0; ai < 2; ++ai)
#pragma unroll
            for (int m = 0; m < 4; ++m) sv[ai][m] = ss[row0 + ai * HALF + m * 16];
#pragma unroll
        for (int ai = 0; ai < 2; ++ai)
#pragma unroll
            for (int m = 0; m < 4; ++m) { bf16_t* rowp = O + (size_t)(row0 + ai * HALF + m * 16) * ldc + col0;
                const float rs = rstd_from(sv[ai][m], 1e-6f);
                const f32x4 g0 = acc[ai][0][m][0] * rs, g1 = acc[ai][0][m][1] * rs, u0 = acc[ai][1][m][0] * rs, u1 = acc[ai][1][m][1] * rs;
                u32x4 w; w.x = cvt_pk_bf16(silu_mul(g0[0], u0[0]), silu_mul(g0[1], u0[1])); w.y = cvt_pk_bf16(silu_mul(g0[2], u0[2]), silu_mul(g0[3], u0[3]));
                w.z = cvt_pk_bf16(silu_mul(g1[0], u1[0]), silu_mul(g1[1], u1[1])); w.w = cvt_pk_bf16(silu_mul(g1[2], u1[2]), silu_mul(g1[3], u1[3]));
                *(u32x4*)rowp = w; }
    }
};
template <bool XN> struct EpiResid {
    static constexpr bool PERM = false, AFTER_DRAIN = false;
    const float* base; int shift; float* out; int ldc; float alpha; int row_off; bf16_t* xn; unsigned long long* ssout;
    __device__ __forceinline__ void operator()(const f32x4 (&acc)[2][2][4][2], const Unit& u, int wr, int wc, int fr, int fq) const {
        typedef unsigned u32x2v __attribute__((ext_vector_type(2)));
        const int row0 = row_off + u.pm * BM + wr * 64 + fr, col0 = u.pn * BM + wc * 32 + 4 * fq;
#pragma unroll
        for (int ai = 0; ai < 2; ++ai) {
            f32x4 b[4][2][2];
#pragma unroll
            for (int m = 0; m < 4; ++m) { const float* brow = base + (size_t)(row0 + ai * HALF + m * 16 - shift) * ldc + col0;
#pragma unroll
                for (int bj = 0; bj < 2; ++bj)
#pragma unroll
                    for (int n = 0; n < 2; ++n) b[m][bj][n] = *(const f32x4*)(brow + bj * HALF + n * 16); }
#pragma unroll
            for (int m = 0; m < 4; ++m) { const int r = row0 + ai * HALF + m * 16; float* orow = out + (size_t)r * ldc + col0; float sq = 0.f;
#pragma unroll
                for (int bj = 0; bj < 2; ++bj)
#pragma unroll
                    for (int n = 0; n < 2; ++n) { const f32x4 o = b[m][bj][n] + acc[ai][bj][m][n] * alpha; *(f32x4*)(orow + bj * HALF + n * 16) = o;
                        if (XN) { u32x2v w; w.x = cvt_pk_bf16(o[0], o[1]); w.y = cvt_pk_bf16(o[2], o[3]); *(u32x2v*)(xn + (size_t)r * ldc + col0 + bj * HALF + n * 16) = w;
                            sq += (o[0] * o[0] + o[1] * o[1]) + (o[2] * o[2] + o[3] * o[3]); } }
                if (XN) { sq += __shfl_xor(sq, 16); sq += __shfl_xor(sq, 32);
                    if (fq == 0) __hip_atomic_fetch_add(ssout + r, (unsigned long long)(sq * 16777216.0f), __ATOMIC_RELAXED, __HIP_MEMORY_SCOPE_AGENT); } }
        }
    }
};
struct EpiProj {
    static constexpr bool PERM = true, AFTER_DRAIN = false;
    bf16_t* P; size_t chunk_stride; float* logit; int row_off; const unsigned long long* ss;
    __device__ __forceinline__ void operator()(const f32x4 (&acc)[2][2][4][2], const Unit& u, int wr, int wc, int fr, int fq) const {
        const int row0 = row_off + u.pm * BM + wr * 64 + fr;
        if (u.pn < 48) {
            unsigned long long sv[2][4];
#pragma unroll
            for (int ai = 0; ai < 2; ++ai)
#pragma unroll
                for (int m = 0; m < 4; ++m) sv[ai][m] = ss[row0 + ai * HALF + m * 16];
#pragma unroll
            for (int ai = 0; ai < 2; ++ai)
#pragma unroll
                for (int m = 0; m < 4; ++m) { const int r = row0 + ai * HALF + m * 16; const float rs = rstd_from(sv[ai][m], 1e-6f);
#pragma unroll
                    for (int bj = 0; bj < 2; ++bj) { bf16_t* dst = P + (size_t)(2 * u.pn + bj) * chunk_stride + (size_t)r * 128 + wc * 32 + 8 * fq;
                        const f32x4 v0 = acc[ai][bj][m][0] * rs, v1 = acc[ai][bj][m][1] * rs;
                        u32x4 w; w.x = cvt_pk_bf16(v0[0], v0[1]); w.y = cvt_pk_bf16(v0[2], v0[3]); w.z = cvt_pk_bf16(v1[0], v1[1]); w.w = cvt_pk_bf16(v1[2], v1[3]);
                        *(u32x4*)dst = w; } }
        } else if (wc == 0 && fq < 2) {
#pragma unroll
            for (int ai = 0; ai < 2; ++ai)
#pragma unroll
                for (int m = 0; m < 4; ++m) { const int r = row0 + ai * HALF + m * 16;
#pragma unroll
                    for (int n = 0; n < 2; ++n) *(f32x4*)(logit + (size_t)r * 16 + 8 * fq + 4 * n) = acc[ai][0][m][n]; }
        }
    }
};
template <class Epi, class Sched, bool ALIGN_EPI = false, bool SP2 = false>
__device__ __forceinline__ void gemm_phase(PG8_LAS unsigned char* lds, const Gemm g, const Sched& S, const Epi& E) {
    const int tid = threadIdx.x, wid = __builtin_amdgcn_readfirstlane(tid >> 6), lane = tid & 63, wr = wid >> 2, wc = wid & 3, fr = lane & 15, fq = lane >> 4;
    const int K = g.K, nt = K / BK;
    unsigned voffA[2], voffB[2];
#pragma unroll
    for (int i = 0; i < 2; ++i) { int R, C; stage_rc(tid * 16 + i * 8192, R, C); const int Rb = Epi::PERM ? ((R & ~31) + perm32(R & 31)) : R;
        voffA[i] = (unsigned)(R * K + C) * 2u; voffB[i] = (unsigned)(Rb * K + C) * 2u; }
    const size_t kstep = (size_t)(BK * 2);
    const size_t hstep = (size_t)HALF * K * 2;
    const size_t tstep = 2 * hstep;
    const unsigned ldsw = (unsigned)wid * 1024u;
    const int aoff = lds_byte(wr * 64 + fr, fq * 8), boff = lds_byte(wc * 32 + fr, fq * 8);
#define PG8_SA(b, h) (((b) * 2 + (h)) * HTB)
#define PG8_SB(b, h) ((4 + (b) * 2 + (h)) * HTB)
#define PG8_STAGE(bufoff, gbase, voff) do { _Pragma("unroll") for (int _i = 0; _i < 2; ++_i) \
        __builtin_amdgcn_global_load_lds((const unsigned*)((const char*)(gbase) + (voff)[_i]), (PG8_LAS unsigned*)(lds + (bufoff) + ldsw + _i * 8192), 16, 0, 0); } while (0)
#define PG8_LDA(dst, b, h) do { _Pragma("unroll") for (int m = 0; m < 4; ++m) _Pragma("unroll") for (int k = 0; k < 2; ++k) dst[m][k] = *(const PG8_LAS bf16x8*)(lds + PG8_SA(b, h) + aoff + m * 2048 + k * 1024); } while (0)
#define PG8_LDB(dst, b, h) do { _Pragma("unroll") for (int n = 0; n < 2; ++n) _Pragma("unroll") for (int k = 0; k < 2; ++k) dst[n][k] = *(const PG8_LAS bf16x8*)(lds + PG8_SB(b, h) + boff + n * 2048 + k * 1024); } while (0)
#define PG8_MMA(ai, bj, At, Bt) do { __builtin_amdgcn_s_setprio(1); _Pragma("unroll") for (int m = 0; m < 4; ++m) _Pragma("unroll") for (int n = 0; n < 2; ++n) _Pragma("unroll") for (int k = 0; k < 2; ++k) \
        acc[ai][bj][m][n] = __builtin_amdgcn_mfma_f32_16x16x32_bf16(Bt[n][k], At[m][k], acc[ai][bj][m][n], 0, 0, 0); __builtin_amdgcn_s_setprio(0); } while (0)
#define PG8_WAIT_V(n) asm volatile("s_waitcnt vmcnt(" #n ")" ::: "memory")
#define PG8_WAIT_L(n) asm volatile("s_waitcnt lgkmcnt(" #n ")" ::: "memory")
#define PG8_BAR __builtin_amdgcn_s_barrier()
#define PG8_SCHED __builtin_amdgcn_sched_barrier(0)
    Unit cur, nxt; int ui = 0;
    if (!S.next(0, cur)) return;
    f32x4 acc[2][2][4][2];
#pragma unroll
    for (int a = 0; a < 2; ++a)
#pragma unroll
        for (int b = 0; b < 2; ++b)
#pragma unroll
            for (int m = 0; m < 4; ++m)
#pragma unroll
                for (int n = 0; n < 2; ++n) acc[a][b][m][n] = (f32x4){0.f, 0.f, 0.f, 0.f};
    bf16x8 At[4][2], B0[2][2], B1[2][2];
    const char* cA = (const char*)g.A + (size_t)cur.pm * tstep; const char* cB = (const char*)g.Bt + (size_t)cur.pn * tstep;
    S.a_ready(cur);
    if constexpr (SP2) {
        PG8_STAGE(PG8_SB(0, 0), cB, voffB); PG8_STAGE(PG8_SB(0, 1), cB + hstep, voffB); PG8_STAGE(PG8_SA(0, 0), cA, voffA); PG8_STAGE(PG8_SA(0, 1), cA + hstep, voffA);
        if (wr == 1) PG8_BAR;
        PG8_WAIT_V(2); PG8_BAR;
        PG8_STAGE(PG8_SB(1, 0), cB + kstep, voffB); PG8_STAGE(PG8_SA(1, 0), cA + kstep, voffA); PG8_STAGE(PG8_SB(1, 1), cB + hstep + kstep, voffB);
        PG8_WAIT_V(6); PG8_BAR;
    } else {
        PG8_STAGE(PG8_SB(0, 0), cB, voffB); PG8_STAGE(PG8_SA(0, 0), cA, voffA); PG8_STAGE(PG8_SB(0, 1), cB + hstep, voffB); PG8_STAGE(PG8_SA(0, 1), cA + hstep, voffA);
        if (wr == 1) PG8_BAR;
        PG8_WAIT_V(4); PG8_BAR;
        PG8_STAGE(PG8_SB(1, 0), cB + kstep, voffB); PG8_STAGE(PG8_SA(1, 0), cA + kstep, voffA); PG8_STAGE(PG8_SB(1, 1), cB + hstep + kstep, voffB);
        PG8_WAIT_V(6); PG8_BAR;
    }
    for (;;) {
        const bool has_next = S.next(ui + 1, nxt);
        const char* nA = has_next ? (const char*)g.A + (size_t)nxt.pm * tstep : cA; const char* nB = has_next ? (const char*)g.Bt + (size_t)nxt.pn * tstep : cB;
        for (int t = 0; t < nt; t += 2) {
            const bool last = (t == nt - 2);
            const char* a1 = cA + (size_t)(t + 1) * kstep;
            const char* a2 = last ? nA : cA + (size_t)(t + 2) * kstep; const char* b2 = last ? nB : cB + (size_t)(t + 2) * kstep;
            const char* a3 = a2 + kstep; const char* b3 = b2 + kstep;
            if (last && has_next) S.a_ready(nxt);
            if constexpr (SP2) {
            PG8_LDB(B0, 0, 0); PG8_LDB(B1, 0, 1); PG8_SCHED; PG8_LDA(At, 0, 0); PG8_STAGE(PG8_SA(1, 1), a1 + hstep, voffA);
            PG8_WAIT_V(8); PG8_WAIT_L(0); PG8_BAR; PG8_MMA(0, 0, At, B0); PG8_MMA(0, 1, At, B1); PG8_BAR; PG8_SCHED;
            PG8_LDA(At, 0, 1); PG8_STAGE(PG8_SB(0, 0), b2, voffB); PG8_STAGE(PG8_SB(0, 1), b2 + hstep, voffB); PG8_STAGE(PG8_SA(0, 0), a2, voffA);
            PG8_WAIT_V(8); PG8_WAIT_L(0); PG8_BAR; PG8_MMA(1, 0, At, B0); PG8_MMA(1, 1, At, B1); PG8_BAR; PG8_SCHED;
            PG8_LDB(B0, 1, 0); PG8_LDB(B1, 1, 1); PG8_SCHED; PG8_LDA(At, 1, 0); PG8_STAGE(PG8_SA(0, 1), a2 + hstep, voffA);
            PG8_WAIT_V(8); PG8_WAIT_L(0); PG8_BAR; PG8_MMA(0, 0, At, B0); PG8_MMA(0, 1, At, B1); PG8_BAR; PG8_SCHED;
            PG8_LDA(At, 1, 1); PG8_STAGE(PG8_SB(1, 0), b3, voffB); PG8_STAGE(PG8_SB(1, 1), b3 + hstep, voffB); PG8_STAGE(PG8_SA(1, 0), a3, voffA);
            PG8_WAIT_V(8); PG8_WAIT_L(0); PG8_BAR; PG8_MMA(1, 0, At, B0); PG8_MMA(1, 1, At, B1); PG8_BAR; PG8_SCHED;
            } else {
            PG8_LDB(B0, 0, 0); PG8_SCHED; PG8_LDA(At, 0, 0); PG8_STAGE(PG8_SA(1, 1), a1 + hstep, voffA);
            PG8_WAIT_L(8); PG8_BAR; PG8_WAIT_L(0); PG8_MMA(0, 0, At, B0); PG8_BAR; PG8_SCHED;
            PG8_LDB(B1, 0, 1); PG8_STAGE(PG8_SB(0, 0), b2, voffB);
            PG8_BAR; PG8_WAIT_L(0); PG8_MMA(0, 1, At, B1); PG8_BAR;
            PG8_LDA(At, 0, 1); PG8_STAGE(PG8_SA(0, 0), a2, voffA);
            PG8_BAR; PG8_WAIT_L(0); PG8_MMA(1, 0, At, B0); PG8_BAR; PG8_SCHED;
            PG8_STAGE(PG8_SB(0, 1), b2 + hstep, voffB);
            PG8_WAIT_V(6); PG8_BAR; PG8_MMA(1, 1, At, B1); PG8_BAR;
            PG8_LDB(B0, 1, 0); PG8_SCHED; PG8_LDA(At, 1, 0); PG8_STAGE(PG8_SA(0, 1), a2 + hstep, voffA);
            PG8_WAIT_L(8); PG8_BAR; PG8_WAIT_L(0); PG8_MMA(0, 0, At, B0); PG8_BAR; PG8_SCHED;
            PG8_LDB(B1, 1, 1); PG8_STAGE(PG8_SB(1, 0), b3, voffB);
            PG8_BAR; PG8_WAIT_L(0); PG8_MMA(0, 1, At, B1); PG8_BAR;
            PG8_LDA(At, 1, 1); PG8_STAGE(PG8_SA(1, 0), a3, voffA);
            PG8_BAR; PG8_WAIT_L(0); PG8_MMA(1, 0, At, B0); PG8_BAR; PG8_SCHED;
            PG8_STAGE(PG8_SB(1, 1), b3 + hstep, voffB);
            PG8_WAIT_V(6); PG8_BAR; PG8_MMA(1, 1, At, B1); PG8_BAR;
            }
        }
        if constexpr (ALIGN_EPI) { if (wr == 0) PG8_BAR; }
        if constexpr (!Epi::AFTER_DRAIN) { E(acc, cur, wr, wc, fr, fq); S.done(cur); }
        if (!has_next) break;
#pragma unroll
        for (int a = 0; a < 2; ++a)
#pragma unroll
            for (int b = 0; b < 2; ++b)
#pragma unroll
                for (int m = 0; m < 4; ++m)
#pragma unroll
                    for (int n = 0; n < 2; ++n) acc[a][b][m][n] = (f32x4){0.f, 0.f, 0.f, 0.f};
        cur = nxt; cA = nA; cB = nB; ++ui;
        if constexpr (ALIGN_EPI) { if (wr == 1) PG8_BAR; }
    }
    PG8_WAIT_V(0);
    if constexpr (!ALIGN_EPI) { if (wr == 0) PG8_BAR; }
    PG8_BAR;
    if constexpr (Epi::AFTER_DRAIN) { E.fused(acc, cur, wr, wc, fr, fq, lds, wid, lane); S.done(cur); }
#undef PG8_SA
#undef PG8_SB
#undef PG8_STAGE
#undef PG8_LDA
#undef PG8_LDB
#undef PG8_MMA
#undef PG8_WAIT_V
#undef PG8_WAIT_L
#undef PG8_BAR
#undef PG8_SCHED
}
}

namespace att {
typedef unsigned short bf16;
typedef short bf16x8 __attribute__((ext_vector_type(8)));
typedef short s16x4 __attribute__((ext_vector_type(4)));
typedef float f32x16 __attribute__((ext_vector_type(16)));
typedef float f32x4 __attribute__((ext_vector_type(4)));
typedef unsigned u32x4 __attribute__((ext_vector_type(4)));
constexpr int D = 128;
constexpr float SCALE = 0.08838834764831845f;
constexpr float THR = 8.f;
constexpr int NW = 8, QBLK = 32, KVBLK = 64, QB = NW * QBLK;
constexpr int SHM_V = KVBLK * D * 2, SHM_K = KVBLK * D * 2;
constexpr int WS_OFF = 2 * SHM_V + 2 * SHM_K;
constexpr int BIAS_OFF = WS_OFF + NW * 64 * 4;
constexpr int BIAS_N = 8448;
constexpr int ATT_LDS_BYTES = BIAS_OFF + BIAS_N * 4;
constexpr int J_LO = 3;
constexpr unsigned WBIG = 1u << 30;
constexpr int OP = 4096;

#define KSWZ(row, colB) ((row) * 256 + ((colB) ^ (((row) & 7) << 4)))
#define SBAR() __builtin_amdgcn_sched_barrier(0)
__device__ __forceinline__ int v_st(int k, int c) { const int kk = (k & ~0xC) | ((k & 4) << 1) | ((k & 8) >> 1); return ((kk >> 3) * 4 + (c >> 5)) * 512 + ((kk & 7) * 32 + (c & 31)) * 2; }
__device__ __forceinline__ int v_rd_base(int lane) { return ((lane & 3) << 3) | (((lane >> 2) & 3) << 6) | (((lane >> 4) & 1) << 5) | (((lane >> 5) & 1) << 8); }
constexpr int v_rd_off(int d0, int ks, int half) { return d0 * 512 + ks * 4096 + half * 2048; }
__device__ __forceinline__ int crow(int r, int hi) { return (r & 3) + 8 * (r >> 2) + 4 * hi; }
__device__ __forceinline__ unsigned cvtpk(float lo, float hi) { unsigned r; asm volatile("v_cvt_pk_bf16_f32 %0, %1, %2" : "=v"(r) : "v"(lo), "v"(hi)); return r; }
__device__ __forceinline__ bf16x8 load8(const bf16* p) { return *reinterpret_cast<const bf16x8*>(p); }
__device__ __forceinline__ void mask_tile(f32x16& p0, f32x16& p1, int dq, unsigned W) {
    const float NEG = -__builtin_inff();
#pragma unroll
    for (int r = 0; r < 16; ++r) {
        const int c = (r & 3) + 8 * (r >> 2);
        if ((unsigned)(dq - c) >= W) p0[r] = NEG;
        if ((unsigned)(dq - c - 32) >= W) p1[r] = NEG;
    }
}
__device__ __forceinline__ void partialSM(f32x16& p0, f32x16& p1, float& m_reg, float& mn, float& alpha) {
    float pmax = p0[0]; for (int r = 1; r < 16; ++r) pmax = fmaxf(pmax, p0[r]); for (int r = 0; r < 16; ++r) pmax = fmaxf(pmax, p1[r]);
    { auto rr = __builtin_amdgcn_permlane32_swap(__float_as_uint(pmax), __float_as_uint(pmax), false, false);
      pmax = fmaxf(__uint_as_float(rr[0]), __uint_as_float(rr[1])); }
    constexpr float C2 = 1.4426950408889634f * SCALE;
    if (__builtin_expect(__all((pmax - m_reg) * SCALE <= THR), 1)) { mn = m_reg; alpha = 1.f; }
    else { mn = fmaxf(m_reg, pmax); alpha = __builtin_amdgcn_exp2f((m_reg - mn) * C2); m_reg = mn; }
    const float mnL = -mn * C2;
    for (int r = 0; r < 16; ++r) p0[r] = fmaf(p0[r], C2, mnL); for (int r = 0; r < 16; ++r) p1[r] = fmaf(p1[r], C2, mnL);
    for (int r = 0; r < 16; ++r) p0[r] = __builtin_amdgcn_exp2f(p0[r]);
}
__device__ __forceinline__ void finishSM(f32x16& p0, f32x16& p1, float alpha, float& l_reg, bf16x8& pa0, bf16x8& pa1, bf16x8& pa2, bf16x8& pa3) {
    for (int r = 0; r < 16; ++r) p1[r] = __builtin_amdgcn_exp2f(p1[r]);
    float ps = 0; for (int r = 0; r < 16; ++r) ps += p0[r]; for (int r = 0; r < 16; ++r) ps += p1[r];
    { auto rr = __builtin_amdgcn_permlane32_swap(__float_as_uint(ps), __float_as_uint(ps), false, false);
      ps = __uint_as_float(rr[0]) + __uint_as_float(rr[1]); }
    l_reg = l_reg * alpha + ps;
#define PK4(P, B_, OUT) do { unsigned a0 = cvtpk(P[B_+0], P[B_+1]), a1 = cvtpk(P[B_+2], P[B_+3]);                          \
        unsigned b0 = cvtpk(P[B_+4], P[B_+5]), b1 = cvtpk(P[B_+6], P[B_+7]);                                             \
        auto r0 = __builtin_amdgcn_permlane32_swap(a0, b0, false, false); auto r1 = __builtin_amdgcn_permlane32_swap(a1, b1, false, false); \
        u32x4 w = {r0[0], r1[0], r0[1], r1[1]}; OUT = *reinterpret_cast<bf16x8*>(&w); } while (0)
    PK4(p0, 0, pa0); PK4(p0, 8, pa1); PK4(p1, 0, pa2); PK4(p1, 8, pa3);
#undef PK4
}
template <int KB>
__device__ __forceinline__ void qkt(f32x16& p0, f32x16& p1, const char* K_lds, int r32, int hi, const bf16x8* qr, const float* bp) {
    {
        const f32x4 a0 = *(const f32x4*)(bp), a1 = *(const f32x4*)(bp + 8), a2 = *(const f32x4*)(bp + 16), a3 = *(const f32x4*)(bp + 24);
        const f32x4 c0 = *(const f32x4*)(bp + 32), c1 = *(const f32x4*)(bp + 40), c2 = *(const f32x4*)(bp + 48), c3 = *(const f32x4*)(bp + 56);
#pragma unroll
        for (int i = 0; i < 4; ++i) { p0[i] = a0[i]; p0[4 + i] = a1[i]; p0[8 + i] = a2[i]; p0[12 + i] = a3[i]; p1[i] = c0[i]; p1[4 + i] = c1[i]; p1[8 + i] = c2[i]; p1[12 + i] = c3[i]; }
    }
    const char* kb[4];
#pragma unroll
    for (int dd = 0; dd < 4; ++dd) kb[dd] = K_lds + KB * SHM_K + KSWZ(r32, (dd * 16 + hi * 8) * 2);
#pragma unroll
    for (int d0 = 0; d0 < 8; ++d0) { const char* a = kb[d0 & 3] + (d0 >> 2) * 128;
        bf16x8 b0 = *reinterpret_cast<const bf16x8*>(a);
        bf16x8 b1 = *reinterpret_cast<const bf16x8*>(a + 32 * 256);
        p0 = __builtin_amdgcn_mfma_f32_32x32x16_bf16(b0, qr[d0], p0, 0, 0, 0);
        p1 = __builtin_amdgcn_mfma_f32_32x32x16_bf16(b1, qr[d0], p1, 0, 0, 0); }
}
template <int VB>
__device__ __forceinline__ void pv_tile(f32x16* o, int vb0, bf16x8 pa0, bf16x8 pa1, bf16x8 pa2, bf16x8 pa3) {
#define TRRD(dst, off) asm volatile("ds_read_b64_tr_b16 %0, %1 offset:%2" : "=&v"(dst) : "v"(vb0), "i"(off) : "memory")
#define PV_D0(d0) do { s16x4 l0, l1, l2, l3, h0, h1, h2, h3; constexpr int b_ = VB * SHM_V + v_rd_off(d0, 0, 0);   \
        TRRD(l0, b_); TRRD(h0, b_ + 2048); TRRD(l1, b_ + 4096); TRRD(h1, b_ + 6144); TRRD(l2, b_ + 8192); TRRD(h2, b_ + 10240); TRRD(l3, b_ + 12288); TRRD(h3, b_ + 14336); \
        asm volatile("s_waitcnt lgkmcnt(0)" ::: "memory"); SBAR();   \
        o[d0] = __builtin_amdgcn_mfma_f32_32x32x16_bf16(pa0, (bf16x8){l0[0], l0[1], l0[2], l0[3], h0[0], h0[1], h0[2], h0[3]}, o[d0], 0, 0, 0);   \
        o[d0] = __builtin_amdgcn_mfma_f32_32x32x16_bf16(pa1, (bf16x8){l1[0], l1[1], l1[2], l1[3], h1[0], h1[1], h1[2], h1[3]}, o[d0], 0, 0, 0);   \
        o[d0] = __builtin_amdgcn_mfma_f32_32x32x16_bf16(pa2, (bf16x8){l2[0], l2[1], l2[2], l2[3], h2[0], h2[1], h2[2], h2[3]}, o[d0], 0, 0, 0);   \
        o[d0] = __builtin_amdgcn_mfma_f32_32x32x16_bf16(pa3, (bf16x8){l3[0], l3[1], l3[2], l3[3], h3[0], h3[1], h3[2], h3[3]}, o[d0], 0, 0, 0); } while (0)
    PV_D0(0); PV_D0(1); PV_D0(2); PV_D0(3);
#undef PV_D0
#undef TRRD
}

struct BlockRef { const bf16* Q; const bf16* K; const bf16* V; bf16* O; int P0; int jlo; };
struct Seam { bf16x8 qr[8]; bf16x8 st_v0, st_v1, st_k0, st_k1; };
#define ROW(p, k0, rr) ((p) + (size_t)((k0) + (rr)) * D + sc)
#define VMW() asm volatile("s_waitcnt vmcnt(0)" ::: "memory")
#define VMWN(n) asm volatile("s_waitcnt vmcnt(%0)" :: "i"(n) : "memory")
#define SLOAD_H(Kp, Vp, k0) do { S.st_v0 = load8(ROW(Vp, k0, sr)); S.st_v1 = load8(ROW(Vp, k0, 32 + sr));              \
                         S.st_k0 = load8(ROW(Kp, k0, sr)); S.st_k1 = load8(ROW(Kp, k0, 32 + sr)); } while (0)
#define SWRITE_HK(bf) do { *(bf16x8*)(K_lds + (bf) * SHM_K + kws) = S.st_k0; *(bf16x8*)(K_lds + (bf) * SHM_K + kws + 32 * 256) = S.st_k1; } while (0)
#define SWRITE_HV(bf) do { *(bf16x8*)(V_lds + (bf) * SHM_V + vst0) = S.st_v0; *(bf16x8*)(V_lds + (bf) * SHM_V + vst1) = S.st_v1; } while (0)
#define SWRITE_H(bf) do { SWRITE_HV(bf); SWRITE_HK(bf); } while (0)
__device__ __forceinline__ void attn_prime(const BlockRef& cur, char* lds, Seam& S) {
    const int tid = threadIdx.x, wid = __builtin_amdgcn_readfirstlane(tid >> 6), lane = tid & 63, r32 = lane & 31, hi = lane >> 5;
    const int sr = tid >> 4, sc = (tid & 15) * 8, kws = KSWZ(sr, sc * 2); char* K_lds = lds + 2 * SHM_V;
    const int kb0 = cur.jlo * KVBLK;
#pragma unroll
    for (int d0 = 0; d0 < 8; ++d0) S.qr[d0] = load8(cur.Q + (size_t)(wid * QBLK + r32) * D + d0 * 16 + hi * 8);
    SLOAD_H(cur.K, cur.V, kb0); VMW(); SWRITE_HK(0);
    __syncthreads();
}
__device__ __forceinline__ void attn_block(const BlockRef& cur, const BlockRef& nxt, char* lds, Seam& S) {
    const int tid = threadIdx.x, wid = __builtin_amdgcn_readfirstlane(tid >> 6), lane = tid & 63, r32 = lane & 31, hi = lane >> 5;
    const int j_lo = cur.jlo;
    const int j_hi = (cur.P0 + QB - 1) / KVBLK + 1;
    const int NT = j_hi - j_lo;
    const int kbn = nxt.jlo * KVBLK;
    const int qlo = cur.P0 + wid * QBLK, qm = qlo + r32 - 4 * hi;
    char* V_lds = lds; char* K_lds = lds + 2 * SHM_V;
    float* ws = (float*)(lds + WS_OFF) + wid * 64; float* li_l = ws, * al_l = ws + 32;
    const float* bias_l = (const float*)(lds + BIAS_OFF) + 4 * hi;
    float m_reg = -1e30f, l_reg = 0; f32x16 o[4] = {};
    const int sr = tid >> 4, sc = (tid & 15) * 8, vst0 = v_st(sr, sc), vst1 = v_st(32 + sr, sc), kws = KSWZ(sr, sc * 2);
    const int vb0 = (int)(uintptr_t)V_lds + v_rd_base(lane);
    const bf16* Kh = cur.K; const bf16* Vh = cur.V;
#define RESC(a) do { if (__any((a) < 1.f)) { if (hi == 0) al_l[r32] = (a); asm volatile("s_waitcnt lgkmcnt(0)" ::: "memory");              \
                     for (int d_ = 0; d_ < 4; ++d_) for (int r = 0; r < 16; ++r) o[d_][r] *= al_l[crow(r, hi)]; } } while (0)
#define KBASE(t) ((j_lo + (t)) * KVBLK)
#define MASKT(P0_, P1_, t) do { const int kb_ = KBASE(t); if (kb_ + KVBLK - 1 > qlo) mask_tile(P0_, P1_, qm - kb_, WBIG); } while (0)
    constexpr int NQL = 8;
#define SEAM_K0() do { VMWN(NQL); SWRITE_HK(0); SBAR(); } while (0)
    f32x16 pA0, pA1, pB0, pB1; float mnA, mnB, alA, alB; bf16x8 pa0, pa1, pa2, pa3;
    SWRITE_HV(0); SBAR();
    if (NT > 1) { SLOAD_H(Kh, Vh, KBASE(1)); }
    SBAR(); qkt<0>(pA0, pA1, K_lds, r32, hi, S.qr, bias_l + KBASE(0));
    MASKT(pA0, pA1, 0); partialSM(pA0, pA1, m_reg, mnA, alA);
    if (NT > 1) { VMW(); SWRITE_H(1); }
    __syncthreads();
#define HALF_STEP(PX0, PX1, mnX, alX, PY0, PY1, alY, t, KB, VB, SB) do {                                                      \
        SBAR(); qkt<KB>(PX0, PX1, K_lds, r32, hi, S.qr, bias_l + KBASE(t));                                                   \
        finishSM(PY0, PY1, alY, l_reg, pa0, pa1, pa2, pa3); SBAR();                                                           \
        if ((t) + 1 < NT) { SLOAD_H(Kh, Vh, KBASE((t) + 1)); SBAR(); }                                                        \
        pv_tile<VB>(o, vb0, pa0, pa1, pa2, pa3); MASKT(PX0, PX1, (t)); partialSM(PX0, PX1, m_reg, mnX, alX);                  \
        __syncthreads();                                                                                                      \
        if ((t) + 1 < NT) { VMW(); SWRITE_H(SB); }                                                                            \
        RESC(alX); __syncthreads(); } while (0)
    for (int t = 1; t + 1 < NT; t += 2) {
        HALF_STEP(pB0, pB1, mnB, alB, pA0, pA1, alA, t, 1, 0, 0);
        HALF_STEP(pA0, pA1, mnA, alA, pB0, pB1, alB, t + 1, 0, 1, 1);
    }
    const bool even = (NT & 1) == 0;
    if (even) { SBAR(); qkt<1>(pB0, pB1, K_lds, r32, hi, S.qr, bias_l + KBASE(NT - 1)); SBAR(); }
    SLOAD_H(nxt.K, nxt.V, kbn); SBAR();
    int tz = threadIdx.x; asm volatile("" : "+v"(tz));
    const int r32b = tz & 31, hib = (tz >> 5) & 1;
    { const bf16* qn = nxt.Q + (unsigned)((wid * QBLK + r32b) * D + hib * 8);
#pragma unroll
    for (int d0 = 0; d0 < 8; ++d0) S.qr[d0] = load8(qn + d0 * 16); }
    SBAR();
    finishSM(pA0, pA1, alA, l_reg, pa0, pa1, pa2, pa3); SBAR();
    pv_tile<0>(o, vb0, pa0, pa1, pa2, pa3);
    if (even) { MASKT(pB0, pB1, NT - 1); partialSM(pB0, pB1, m_reg, mnB, alB); __syncthreads(); RESC(alB);
        finishSM(pB0, pB1, alB, l_reg, pa0, pa1, pa2, pa3); SBAR(); pv_tile<1>(o, vb0, pa0, pa1, pa2, pa3); }
    SBAR(); SEAM_K0();
    if (hi == 0) li_l[r32] = l_reg; asm volatile("s_waitcnt lgkmcnt(0)" ::: "memory");
    float rli[16];
#pragma unroll
    for (int r = 0; r < 16; ++r) rli[r] = __builtin_amdgcn_rcpf(li_l[crow(r, hi)]);
    bf16* Ow = cur.O + (size_t)(wid * QBLK) * OP + (unsigned)(4 * hib * OP + r32b);
#pragma unroll
    for (int r = 0; r < 16; ++r) { const int orow0 = (r & 3) + 8 * (r >> 2);
#pragma unroll
        for (int d0 = 0; d0 < 4; ++d0) { const float v = o[d0][r] * rli[r];
            const float vn = __shfl_xor(v, 1);
            if ((r32b & 1) == 0) *(unsigned*)(Ow + orow0 * OP + d0 * 32) = cvtpk(v, vn); } }
    __syncthreads();
#undef RESC
#undef KBASE
#undef MASKT
#undef SEAM_K0
#undef HALF_STEP
}
#undef ROW
#undef VMW
#undef VMWN
#undef SLOAD_H
#undef SWRITE_HK
#undef SWRITE_HV
#undef SWRITE_H
#undef KSWZ
#undef SBAR
}

constexpr int NWAVES = 8;
constexpr int N_LAUNCHES = MK_N_LAUNCHES;
constexpr int N_PHASES = 13;
constexpr int DM = 4096, SEQ = 8192, NMETA = 16, DFF = 11008, NGU = 2 * DFF, INCOLS = 12304, NQKV = 12288, NIN = 12544, HD = 128;
constexpr int PADF = 240, XR0 = 256, MP = 8448;
constexpr int NCHUNK = 96;
constexpr float RMS_EPS = 1e-6f, SUBLN_EPS = 1e-5f, LAMBDA_INIT = 0.2f;
constexpr float INV_SCALE = 11.313708498984761f;

constexpr size_t MiB = 1u << 20;
constexpr size_t WS_CTL = 0, CTL_ZERO_BYTES = 1 * MiB;
constexpr size_t SZ_WGU = (size_t)NGU * DM * 2, SZ_WD = (size_t)DM * DFF * 2, SZ_WIN = (size_t)NIN * DM * 2, SZ_WOUT = (size_t)DM * DM * 2;
constexpr size_t WS_W1GU = 1 * MiB, WS_W1D = WS_W1GU + SZ_WGU, WS_WIN = WS_W1D + SZ_WD, WS_WOUT = WS_WIN + SZ_WIN, WS_W2GU = WS_WOUT + SZ_WOUT, WS_W2D = WS_W2GU + SZ_WGU;
constexpr size_t WS_H = WS_W2D + SZ_WD;
constexpr size_t WS_XN = WS_H + (size_t)MP * DM * 4;
constexpr size_t WS_BIG = WS_XN + (size_t)MP * DM * 2;
constexpr size_t SZ_BIG = (size_t)NCHUNK * MP * HD * 2;
constexpr size_t WS_O = WS_BIG + SZ_BIG;
constexpr size_t WS_O1 = WS_O + (size_t)MP * DM * 2;
constexpr size_t WS_LOGIT = WS_O1 + (size_t)MP * DM * 2;
constexpr size_t WS_BIAS = WS_LOGIT + (size_t)MP * 16 * 4;
constexpr size_t WS_END = WS_BIAS + (size_t)24 * MP * 4;
static_assert((size_t)MP * DFF * 2 <= SZ_BIG, "FFN hidden fits the shared region");
static_assert(WS_W1GU % 256 == 0 && WS_W1D % 256 == 0 && WS_WIN % 256 == 0 && WS_H % 256 == 0 && WS_XN % 256 == 0 && WS_BIG % 256 == 0 && WS_O % 256 == 0 && WS_LOGIT % 256 == 0 && WS_BIAS % 256 == 0, "alignment");
constexpr int CW_BAR = 4096;
constexpr int CW_QUEUE = 8192;
constexpr int CW_T1Q = 9216, CW_CONVQ = 9280;
constexpr int CW_NORM = 12288;

constexpr int RING_OFF = 0, RING_BYTES = 135168;
constexpr int LDSCTL_OFF = RING_BYTES, MISC_OFF = LDSCTL_OFF + 320;
constexpr int LDS_BYTES = 147456;
static_assert(MISC_OFF + 128 <= LDS_BYTES && att::ATT_LDS_BYTES <= RING_BYTES, "LDS map");

#define GAS __attribute__((address_space(1)))
#define LAS __attribute__((address_space(3)))
typedef unsigned short bf16;
typedef unsigned v4u __attribute__((ext_vector_type(4)));
typedef unsigned v2u __attribute__((ext_vector_type(2)));
typedef float f32x4 __attribute__((ext_vector_type(4)));
typedef GAS unsigned gu32;
#define RLX_AGENT __ATOMIC_RELAXED, __HIP_MEMORY_SCOPE_AGENT
#define LDS_WAIT() asm volatile("s_waitcnt lgkmcnt(0)" ::: "memory")
#define VM_WAIT() asm volatile("s_waitcnt vmcnt(0)" ::: "memory")
__device__ __forceinline__ unsigned f2bf(float f) { unsigned u = __builtin_bit_cast(unsigned, f); return (u + 0x7fffu + ((u >> 16) & 1u)) >> 16; }
__device__ __forceinline__ unsigned pk2(float lo, float hi) { return f2bf(lo) | (f2bf(hi) << 16); }
__device__ __forceinline__ float bf_lo(unsigned w) { return __builtin_bit_cast(float, w << 16); }
__device__ __forceinline__ float bf_hi(unsigned w) { return __builtin_bit_cast(float, w & 0xffff0000u); }
#define XB_TMO      128
#define XB_XCNT(j)  (256  + 64 * (j))
#define XB_XSUB(j)  (1280 + 64 * (j))
#define XB_XGEN(j)  (2304 + 64 * (j))
#define XB_TOP      3328
#define XB_TOPGEN   3392
#define XCD_BAR_WORDS 3456
#define XB_SPIN_CAP (1u << 18)

__device__ __forceinline__ unsigned xb_ld(unsigned* p)              { return __hip_atomic_load(p, __ATOMIC_RELAXED, __HIP_MEMORY_SCOPE_AGENT); }
__device__ __forceinline__ unsigned xb_add(unsigned* p, unsigned v) { return __hip_atomic_fetch_add(p, v, __ATOMIC_RELAXED, __HIP_MEMORY_SCOPE_AGENT); }
__device__ __forceinline__ unsigned xb_xcc_id() { return (unsigned)__builtin_amdgcn_s_getreg((3 << 11) | 20) & 0xFu; }
#define XB_SPIN(cond, bar) do { unsigned _sp = 0; while (cond) { __builtin_amdgcn_s_sleep(1); \
    if ((++_sp & 255u) == 0u) { if (xb_ld(&(bar)[XB_TMO])) break; if (_sp > XB_SPIN_CAP) { atomicAdd(&(bar)[XB_TMO], 1u); break; } } } } while (0)

struct XcdBarrier {
    unsigned* bar; unsigned x;
    volatile LAS unsigned* st;
};

__device__ __forceinline__ XcdBarrier xcd_barrier_post(unsigned* bar, volatile LAS unsigned* st) {
    XcdBarrier b; b.bar = bar; b.x = xb_xcc_id(); b.st = st;
    if (threadIdx.x == 0) (void)xb_add(&bar[XB_XCNT(b.x)], 1u);
    return b;
}
__device__ __forceinline__ void xcd_barrier_complete(unsigned* bar, unsigned x, unsigned& nloc, unsigned& nx) {
    const unsigned G = gridDim.x * gridDim.y * gridDim.z;
    unsigned sum, cnt, mine, sp = 0u;
    for (;;) {
        sum = 0u; cnt = 0u; mine = 0u;
#pragma unroll
        for (unsigned j = 0; j < 16; ++j) { const unsigned c = xb_ld(&bar[XB_XCNT(j)]); sum += c; cnt += (c > 0u) ? 1u : 0u; mine = (j == x) ? c : mine; }
        if (sum == G) break;
        __builtin_amdgcn_s_sleep(1);
        if ((++sp & 255u) == 0u) { if (xb_ld(&bar[XB_TMO])) break; if (sp > XB_SPIN_CAP) { atomicAdd(&bar[XB_TMO], 1u); break; } }
    }
    nloc = mine > 0u ? mine : 1u; nx = cnt > 0u ? cnt : 1u;
}

__device__ __forceinline__ void xcd_barrier(const XcdBarrier& b) {
    asm volatile("s_waitcnt vmcnt(0)" ::: "memory");
    __syncthreads();
    if (threadIdx.x == 0) {
        unsigned* bar = b.bar;
        __builtin_amdgcn_s_waitcnt(0);
        unsigned nloc = b.st[0], nx = b.st[1];
        if (nloc == 0u) { xcd_barrier_complete(bar, b.x, nloc, nx); b.st[0] = nloc; b.st[1] = nx; }
        const unsigned old = xb_add(&bar[XB_XSUB(b.x)], 1u);
        const unsigned gen = old / nloc;
        if (old + 1u == (gen + 1u) * nloc) {
            __builtin_amdgcn_fence(__ATOMIC_RELEASE, "agent");
            asm volatile("s_waitcnt vmcnt(0)" ::: "memory");
            const unsigned og = xb_add(&bar[XB_TOP], 1u);
            const unsigned tg = og / nx;
            if (og + 1u == (tg + 1u) * nx) xb_add(&bar[XB_TOPGEN], 1u);
            else XB_SPIN(xb_ld(&bar[XB_TOPGEN]) == tg, bar);
            __builtin_amdgcn_fence(__ATOMIC_ACQUIRE, "agent");
            xb_add(&bar[XB_XGEN(b.x)], 1u);
            asm volatile("s_waitcnt vmcnt(0)" ::: "memory");
        } else {
            XB_SPIN(xb_ld(&bar[XB_XGEN(b.x)]) == gen, bar);
            __builtin_amdgcn_fence(__ATOMIC_ACQUIRE, "agent");
            asm volatile("s_waitcnt vmcnt(0)" ::: "memory");
        }
    }
    __syncthreads();
}


struct Frame {
    LAS unsigned char* lds;
    volatile LAS unsigned* MISC;
    gu32* ctl;
    int tid, lane, wave;
    int vcu, G;
};
__device__ __forceinline__ float wave_sum(float v) {
#pragma unroll
    for (int o = 1; o < 64; o <<= 1) v += __shfl_xor(v, o);
    return v;
}
struct TItem { const float* src; bf16* dst; const float* gain; int ldw, K, ncol, pad; };
__device__ __forceinline__ void t_load(f32x4 (&v)[16], const TItem& t, int lane) {
    const int q = lane & 15, g = lane >> 4; const bool ok = 4 * q < t.ncol;
    const float* p = t.src + (size_t)g * t.ldw + 4 * q;
#pragma unroll
    for (int i = 0; i < 16; ++i) v[i] = ok ? __builtin_nontemporal_load((const GAS f32x4*)(p + (size_t)(4 * i) * t.ldw)) : (f32x4){0.f, 0.f, 0.f, 0.f};
}
__device__ __forceinline__ void t_store(const f32x4 (&v)[16], const TItem& t, LAS float* scr, int lane) {
    const int q = lane & 15, g = lane >> 4;
    LAS float* w = scr + g * 65 + 4 * q;
#pragma unroll
    for (int i = 0; i < 16; ++i) { w[(4 * i) * 65 + 0] = v[i].x; w[(4 * i) * 65 + 1] = v[i].y; w[(4 * i) * 65 + 2] = v[i].z; w[(4 * i) * 65 + 3] = v[i].w; }
    LDS_WAIT(); asm volatile("" ::: "memory");
    const int c = lane & 7, nn = lane >> 3;
    const LAS float* s = scr + (8 * c) * 65 + nn;
    bf16* d = t.dst + (size_t)nn * t.K + 8 * c;
    f32x4 ga = {1.f, 1.f, 1.f, 1.f}, gb = {1.f, 1.f, 1.f, 1.f};
    if (t.gain) { ga = *(const GAS f32x4*)(t.gain + 8 * c); gb = *(const GAS f32x4*)(t.gain + 8 * c + 4); }
#pragma unroll
    for (int j = 0; j < 8; ++j) { v4u o;
        o.x = pg8::cvt_pk_bf16(s[8 * j + 0 * 65] * ga.x, s[8 * j + 1 * 65] * ga.y); o.y = pg8::cvt_pk_bf16(s[8 * j + 2 * 65] * ga.z, s[8 * j + 3 * 65] * ga.w);
        o.z = pg8::cvt_pk_bf16(s[8 * j + 4 * 65] * gb.x, s[8 * j + 5 * 65] * gb.y); o.w = pg8::cvt_pk_bf16(s[8 * j + 6 * 65] * gb.z, s[8 * j + 7 * 65] * gb.w);
        __builtin_nontemporal_store(o, (GAS v4u*)(d + (size_t)(8 * j) * t.K)); }
    LDS_WAIT(); asm volatile("" ::: "memory");
}
__device__ __forceinline__ TItem t_item(const float* W, int ldw, int K, int nblk, int ncols, bf16* WT, int blk, int off, int r, const float* gain) {
    const int kb = r / nblk, nb = r - kb * nblk, n0 = 64 * nb;
    TItem t; t.src = W + (size_t)(64 * kb) * ldw + n0; t.dst = WT + (size_t)((n0 >> 7) * blk + off + (n0 & 127)) * K + 64 * kb; t.ldw = ldw; t.K = K;
    t.ncol = (ncols - n0) < 64 ? (ncols - n0) : 64; t.pad = 0; t.gain = gain ? gain + 64 * kb : nullptr; return t;
}
__device__ __forceinline__ void raw_row_bf16(const float* xrow, bf16* orow, unsigned long long* ss, int lane) {
    const GAS f32x4* xr = (const GAS f32x4*)xrow + lane;
    f32x4 v[16]; float s = 0.f;
#pragma unroll
    for (int j = 0; j < 16; ++j) { v[j] = xr[64 * j]; s += (v[j].x * v[j].x + v[j].y * v[j].y) + (v[j].z * v[j].z + v[j].w * v[j].w); }
    s = wave_sum(s);
    GAS v2u* o8 = (GAS v2u*)orow + lane;
#pragma unroll
    for (int j = 0; j < 16; ++j) { v2u w; w.x = pg8::cvt_pk_bf16(v[j].x, v[j].y); w.y = pg8::cvt_pk_bf16(v[j].z, v[j].w); o8[64 * j] = w; }
    if (lane == 0) *ss = (unsigned long long)(s * 16777216.0f);
}
__device__ __forceinline__ void norm_row_bf16(const float* xrow, const float* gain, bf16* orow, int lane, float eps) {
    const GAS f32x4* xr = (const GAS f32x4*)xrow + lane; const GAS f32x4* gr = (const GAS f32x4*)gain + lane;
    f32x4 v[16]; float s = 0.f;
#pragma unroll
    for (int j = 0; j < 16; ++j) { v[j] = xr[64 * j]; s += (v[j].x * v[j].x + v[j].y * v[j].y) + (v[j].z * v[j].z + v[j].w * v[j].w); }
    const float r = 1.0f / sqrtf(wave_sum(s) * (1.0f / DM) + eps);
    GAS v2u* o8 = (GAS v2u*)orow + lane;
#pragma unroll
    for (int j = 0; j < 16; ++j) { const f32x4 g = gr[64 * j]; v2u w; w.x = pk2(v[j].x * r * g.x, v[j].y * r * g.y); w.y = pk2(v[j].z * r * g.z, v[j].w * r * g.w); o8[64 * j] = w; }
}
__device__ __forceinline__ void norm_row_f32(const float* xrow, const float* gain, float* orow, int lane, float eps) {
    const GAS f32x4* xr = (const GAS f32x4*)xrow + lane; const GAS f32x4* gr = (const GAS f32x4*)gain + lane;
    f32x4 v[16]; float s = 0.f;
#pragma unroll
    for (int j = 0; j < 16; ++j) { v[j] = xr[64 * j]; s += (v[j].x * v[j].x + v[j].y * v[j].y) + (v[j].z * v[j].z + v[j].w * v[j].w); }
    const float r = 1.0f / sqrtf(wave_sum(s) * (1.0f / DM) + eps);
    GAS f32x4* o = (GAS f32x4*)orow + lane;
#pragma unroll
    for (int j = 0; j < 16; ++j) { const f32x4 g = gr[64 * j]; f32x4 w; w.x = v[j].x * r * g.x; w.y = v[j].y * r * g.y; w.z = v[j].z * r * g.z; w.w = v[j].w * r * g.w; o[64 * j] = w; }
}


typedef short bf16x8_t __attribute__((ext_vector_type(8)));
__device__ __forceinline__ f32x4 thin16(const bf16* a, const bf16* b, int nsteps) {
    f32x4 acc = {0.f, 0.f, 0.f, 0.f};
    int s = 0;
    for (; s + 16 <= nsteps; s += 16) {
        bf16x8_t av[16], bv[16];
#pragma unroll
        for (int u = 0; u < 16; ++u) { av[u] = *(const GAS bf16x8_t*)(a + (s + u) * 32); bv[u] = *(const GAS bf16x8_t*)(b + (s + u) * 32); }
#pragma unroll
        for (int u = 0; u < 16; ++u) acc = __builtin_amdgcn_mfma_f32_16x16x32_bf16(av[u], bv[u], acc, 0, 0, 0);
    }
    if (s < nsteps) {
        bf16x8_t av[15], bv[15];
#pragma unroll
        for (int u = 0; u < 15; ++u) if (s + u < nsteps) { av[u] = *(const GAS bf16x8_t*)(a + (s + u) * 32); bv[u] = *(const GAS bf16x8_t*)(b + (s + u) * 32); }
#pragma unroll
        for (int u = 0; u < 15; ++u) if (s + u < nsteps) acc = __builtin_amdgcn_mfma_f32_16x16x32_bf16(av[u], bv[u], acc, 0, 0, 0);
    }
    return acc;
}
__device__ __forceinline__ void thin16x2(const bf16* a, const bf16* b0, const bf16* b1, int nsteps, f32x4& acc0, f32x4& acc1) {
    acc0 = (f32x4){0.f, 0.f, 0.f, 0.f}; acc1 = (f32x4){0.f, 0.f, 0.f, 0.f};
    for (int s = 0; s + 8 <= nsteps; s += 8) {
        bf16x8_t av[8], bv[8], cv[8];
#pragma unroll
        for (int u = 0; u < 8; ++u) { av[u] = *(const GAS bf16x8_t*)(a + (s + u) * 32); bv[u] = *(const GAS bf16x8_t*)(b0 + (s + u) * 32); cv[u] = *(const GAS bf16x8_t*)(b1 + (s + u) * 32); }
#pragma unroll
        for (int u = 0; u < 8; ++u) { acc0 = __builtin_amdgcn_mfma_f32_16x16x32_bf16(av[u], bv[u], acc0, 0, 0, 0); acc1 = __builtin_amdgcn_mfma_f32_16x16x32_bf16(av[u], cv[u], acc1, 0, 0, 0); }
    }
}
__device__ __forceinline__ float thin_reduce(LAS float* red, f32x4 acc, int tid, int lane, int wave) {
    *(LAS f32x4*)(red + wave * 256 + lane * 4) = acc;
    __syncthreads();
    float s = 0.f;
    if (tid < 256) {
#pragma unroll
        for (int w = 0; w < 8; ++w) s += red[w * 256 + tid];
    }
    __syncthreads();
    return s;
}
__device__ __forceinline__ int hidden_tid() { int t = threadIdx.x; asm volatile("" : "+v"(t)); return t; }
struct Args { const float* in[20]; float* out; unsigned char* ws; int ph_lo, ph_hi; };

__global__ void __launch_bounds__(NWAVES * 64, 2) hymba_fwd(Args args) {
    extern __shared__ __attribute__((aligned(16))) unsigned char lds[];
    Frame F;
    F.lds = (LAS unsigned char*)lds;
    F.MISC = (volatile LAS unsigned*)(F.lds + MISC_OFF);
    F.tid = threadIdx.x; F.lane = F.tid & 63; F.wave = __builtin_amdgcn_readfirstlane(F.tid >> 6);
    F.G = gridDim.x; { const int bx = blockIdx.x; F.vcu = (F.G % 8 == 0) ? (bx % 8) * (F.G / 8) + bx / 8 : bx; }
    unsigned char* ws = args.ws;
    F.ctl = (gu32*)(ws + WS_CTL);
    const float* x = args.in[0]; const float* meta = args.in[1];
    bf16* W1GU = (bf16*)(ws + WS_W1GU); bf16* W1D = (bf16*)(ws + WS_W1D); bf16* WIN = (bf16*)(ws + WS_WIN); bf16* WOUT = (bf16*)(ws + WS_WOUT);
    bf16* W2GU = (bf16*)(ws + WS_W2GU); bf16* W2D = (bf16*)(ws + WS_W2D);
    float* H = (float*)(ws + WS_H); bf16* XN = (bf16*)(ws + WS_XN); bf16* ACT = (bf16*)(ws + WS_BIG); bf16* PROJ = (bf16*)(ws + WS_BIG);
    bf16* OB = (bf16*)(ws + WS_O); bf16* O1B = (bf16*)(ws + WS_O1); float* LOGIT = (float*)(ws + WS_LOGIT); float* BIAS = (float*)(ws + WS_BIAS);
    unsigned long long* SS0 = (unsigned long long*)(ws + WS_CTL + 256 * 1024); unsigned long long* SS1 = (unsigned long long*)(ws + WS_CTL + 384 * 1024); unsigned long long* SS2 = (unsigned long long*)(ws + WS_CTL + 512 * 1024);
    for (int u = F.tid; u < (LDS_BYTES - LDSCTL_OFF) / 4; u += NWAVES * 64) ((LAS unsigned*)(F.lds + LDSCTL_OFF))[u] = 0u;
    __syncthreads();
    XcdBarrier bar; bar.bar = (unsigned*)(F.ctl + CW_BAR); bar.x = 0; bar.st = nullptr;
    if (N_LAUNCHES == 1) bar = xcd_barrier_post((unsigned*)(F.ctl + CW_BAR), F.MISC + 8);
#define GRID_BAR() do { if (N_LAUNCHES == 1) xcd_barrier(bar); } while (0)
    const int lo = args.ph_lo, hi = args.ph_hi;
#define IN(k) (lo <= (k) && (k) < hi)
#define BOTH(k) (IN(k) && IN((k) + 1))
    const int gw = F.vcu * NWAVES + F.wave, NGW = F.G * NWAVES;

    constexpr int I_GU = (DM / 64) * (DFF / 64), I_D = (DFF / 64) * (DM / 64), I_IN = (DM / 64) * 193, I_OUT = (DM / 64) * (DM / 64);
    constexpr int NITEMS = 4 * I_GU + 2 * I_D + I_IN + I_OUT, N0 = 2 * I_GU;
#define T_DECODE(T_, it_) do { int r_ = (it_);                                                                                     \
            if (r_ < I_GU) { T_ = t_item(args.in[3], DFF, DM, DFF / 64, DFF, W1GU, 256, 0, r_, args.in[2]); break; } r_ -= I_GU;                 \
            if (r_ < I_GU) { T_ = t_item(args.in[4], DFF, DM, DFF / 64, DFF, W1GU, 256, 128, r_, args.in[2]); break; } r_ -= I_GU;               \
            if (r_ < I_D) { T_ = t_item(args.in[5], DM, DFF, DM / 64, DM, W1D, 128, 0, r_, nullptr); break; } r_ -= I_D;                      \
            if (r_ < I_IN) { T_ = t_item(args.in[7], INCOLS, DM, 193, INCOLS, WIN, 128, 0, r_, args.in[6]); break; } r_ -= I_IN;                 \
            if (r_ < I_OUT) { T_ = t_item(args.in[14], DM, DM, DM / 64, DM, WOUT, 128, 0, r_, nullptr); break; } r_ -= I_OUT;                 \
            if (r_ < I_GU) { T_ = t_item(args.in[16], DFF, DM, DFF / 64, DFF, W2GU, 256, 0, r_, args.in[15]); break; } r_ -= I_GU;                \
            if (r_ < I_GU) { T_ = t_item(args.in[17], DFF, DM, DFF / 64, DFF, W2GU, 256, 128, r_, args.in[15]); break; } r_ -= I_GU;              \
            T_ = t_item(args.in[18], DM, DFF, DM / 64, DM, W2D, 128, 0, r_, nullptr); } while (0)
    if (IN(0)) {
        const int tid = hidden_tid(), lane = tid & 63; (void)tid; (void)lane;
        LAS float* scr = (LAS float*)(F.lds + RING_OFF + F.wave * 16640);
        {
            f32x4 va[16], vb[16]; TItem ta, tb;
            int it = gw;
            if (it < N0) {
                T_DECODE(ta, it); t_load(va, ta, lane);
                for (;;) {
                    const int itn = it + NGW;
                    if (itn < N0) { T_DECODE(tb, itn); t_load(vb, tb, lane); }
                    t_store(va, ta, scr, lane);
                    if (itn >= N0) break;
                    const int it2 = itn + NGW;
                    if (it2 < N0) { T_DECODE(ta, it2); t_load(va, ta, lane); }
                    t_store(vb, tb, scr, lane);
                    if (it2 >= N0) break;
                    it = it2;
                }
            }
        }
        { GAS v4u* z = (GAS v4u*)(WIN + (size_t)12352 * DM); const size_t n16 = (size_t)(NIN - 12352) * DM * 2 / 16;
          for (size_t i = (size_t)blockIdx.x * 512 + tid; i < n16; i += (size_t)F.G * 512) z[i] = (v4u){0u, 0u, 0u, 0u}; }
        for (int m = PADF + gw; m < MP; m += NGW)
            raw_row_bf16(m < XR0 ? meta + (size_t)(m - PADF) * DM : x + (size_t)(m - XR0) * DM, XN + (size_t)m * DM, SS0 + m, lane);
        if (BOTH(0)) GRID_BAR();
    }
    if (IN(1)) {
        constexpr int GG = 224;
        const int tid = hidden_tid(), lane = tid & 63;
        volatile LAS int* MQ = (volatile LAS int*)(F.lds + MISC_OFF) + 16;
        if ((int)blockIdx.x < GG) {
            pg8::Gemm g{XN + (size_t)XR0 * DM, W1GU, SEQ, NGU, DM}; pg8::StaticOrder S; S.init(SEQ, NGU, GG, (int)blockIdx.x);
            pg8::EpiSwiGLU E{ACT, DFF, XR0, SS0};
            pg8::gemm_phase<pg8::EpiSwiGLU, pg8::StaticOrder, true, true>(F.lds + RING_OFF, g, S, E);
        }
        {
            LAS float* red = (LAS float*)(F.lds + RING_OFF);
            const bf16* a = XN + (size_t)(PADF + (lane & 15)) * DM + 512 * F.wave + 8 * (lane >> 4);
            for (;;) {
                if (tid == 0) MQ[4] = (int)__hip_atomic_fetch_add((unsigned*)(F.ctl + CW_T1Q), 4u, RLX_AGENT);
                __syncthreads();
                const int cb0 = MQ[4];
                if (cb0 >= DFF / 16) break;
                f32x4 ag[4], au[4];
#pragma unroll
                for (int i = 0; i < 4; ++i) { const int c0 = 16 * (cb0 + i); const bf16* b0 = W1GU + (size_t)((c0 >> 7) * 256 + (c0 & 127) + (lane & 15)) * DM + 512 * F.wave + 8 * (lane >> 4);
                    thin16x2(a, b0, b0 + (size_t)128 * DM, 16, ag[i], au[i]); }
#pragma unroll
                for (int i = 0; i < 4; ++i) { *(LAS f32x4*)(red + ((2 * i) * 8 + F.wave) * 256 + lane * 4) = ag[i]; *(LAS f32x4*)(red + ((2 * i + 1) * 8 + F.wave) * 256 + lane * 4) = au[i]; }
                __syncthreads();
                if (tid < 256) { const int l = tid >> 2, tok = 4 * (l >> 4) + (tid & 3), col = l & 15; const float rs = pg8::rstd_of(SS0, PADF + tok, RMS_EPS);
#pragma unroll
                    for (int i = 0; i < 4; ++i) { float gs = 0.f, us = 0.f;
#pragma unroll
                        for (int w = 0; w < 8; ++w) { gs += red[((2 * i) * 8 + w) * 256 + tid]; us += red[((2 * i + 1) * 8 + w) * 256 + tid]; }
                        ACT[(size_t)(PADF + tok) * DFF + 16 * (cb0 + i) + col] = (bf16)f2bf(pg8::silu_mul(gs * rs, us * rs)); } }
                __syncthreads();
            }
            __syncthreads();
        }
        {
            LAS float* scr = (LAS float*)(F.lds + RING_OFF + F.wave * 16640);
            constexpr int NQ = NITEMS - N0, CHK = 8;
            int q_it = 0, q_end = 0, q_next = 0;
#define Q_POP(dst_) do { int v_ = 0; if (lane == 0) v_ = (int)__hip_atomic_fetch_add((unsigned*)(F.ctl + CW_CONVQ), (unsigned)CHK, RLX_AGENT); dst_ = __builtin_amdgcn_readfirstlane(v_); } while (0)
#define Q_NEXT(dst_) do { if (q_it >= q_end) { if (q_next < NQ) { q_it = q_next; q_end = (q_next + CHK) < NQ ? (q_next + CHK) : NQ; Q_POP(q_next); } } \
                          if (q_it < q_end) { dst_ = q_it; ++q_it; } else dst_ = -1; } while (0)
            Q_POP(q_next);
            f32x4 va[16], vb[16], vc[16]; TItem ta, tb, tc; int i0, i1, i2;
            Q_NEXT(i0); if (i0 >= 0) { T_DECODE(ta, N0 + i0); t_load(va, ta, lane); }
            Q_NEXT(i1); if (i1 >= 0) { T_DECODE(tb, N0 + i1); t_load(vb, tb, lane); }
            for (;;) {
                if (i0 < 0) break;
                Q_NEXT(i2); if (i2 >= 0) { T_DECODE(tc, N0 + i2); t_load(vc, tc, lane); }
                t_store(va, ta, scr, lane);
                if (i1 < 0) break;
                Q_NEXT(i0); if (i0 >= 0) { T_DECODE(ta, N0 + i0); t_load(va, ta, lane); }
                t_store(vb, tb, scr, lane);
                if (i2 < 0) break;
                Q_NEXT(i1); if (i1 >= 0) { T_DECODE(tb, N0 + i1); t_load(vb, tb, lane); }
                t_store(vc, tc, scr, lane);
            }
#undef Q_POP
#undef Q_NEXT
        }
        if (BOTH(1)) GRID_BAR();
    }
    if (IN(2)) {
        pg8::Gemm g{ACT + (size_t)XR0 * DFF, W1D, SEQ, DM, DFF}; pg8::StaticOrder S; S.init(SEQ, DM, F.G, (int)blockIdx.x);
        pg8::EpiResid<true> E{x, XR0, H, DM, 0.5f, XR0, XN, SS1};
        pg8::gemm_phase<pg8::EpiResid<true>, pg8::StaticOrder, true, true>(F.lds + RING_OFF, g, S, E);
        {
            const int tid = hidden_tid(), lane = tid & 63;
            LAS float* red = (LAS float*)(F.lds + RING_OFF);
            const bf16* a = ACT + (size_t)(PADF + (lane & 15)) * DFF + 1376 * F.wave + 8 * (lane >> 4);
            for (int cb = blockIdx.x; cb < DM / 16; cb += F.G) {
                const int c0 = 16 * cb; const bf16* b = W1D + (size_t)(c0 + (lane & 15)) * DFF + 1376 * F.wave + 8 * (lane >> 4);
                const float sum = thin_reduce(red, thin16(a, b, 43), tid, lane, F.wave);
                if (tid < 256) { const int l = tid >> 2, tok = 4 * (l >> 4) + (tid & 3), col = l & 15; const float hv = meta[(size_t)tok * DM + c0 + col] + 0.5f * sum;
                    H[(size_t)(PADF + tok) * DM + c0 + col] = hv; XN[(size_t)(PADF + tok) * DM + c0 + col] = (bf16)f2bf(hv);
                    float sq = hv * hv; sq += __shfl_xor(sq, 4); sq += __shfl_xor(sq, 8); sq += __shfl_xor(sq, 16); sq += __shfl_xor(sq, 32);
                    if (col == 0) __hip_atomic_fetch_add(SS1 + PADF + tok, (unsigned long long)(sq * 16777216.0f), RLX_AGENT); }
            }
        }
        if (BOTH(2)) GRID_BAR();
    }
    if (IN(4)) {
        pg8::Gemm g{XN + (size_t)XR0 * DM, WIN, SEQ, NQKV, DM}; pg8::StaticOrder S; S.init(SEQ, NQKV, F.G, (int)blockIdx.x);
        pg8::EpiProj E{PROJ, (size_t)MP * HD, LOGIT, XR0, SS1};
        pg8::gemm_phase<pg8::EpiProj, pg8::StaticOrder, true, true>(F.lds + RING_OFF, g, S, E);
        {
            const int tid = hidden_tid(), lane = tid & 63;
            LAS float* red = (LAS float*)(F.lds + RING_OFF);
            const size_t CH = (size_t)MP * HD;
            constexpr int NTASK = 513 + SEQ / 16;
            f32x4 accs[5];
#pragma unroll
            for (int i = 0; i < 5; ++i) { const int t = (int)blockIdx.x + i * F.G; accs[i] = (f32x4){0.f, 0.f, 0.f, 0.f};
                if (t < NTASK) { int arow, brow; if (t < 512) { const int kc = t >> 3, chunk = kc < 32 ? 16 + kc : 32 + kc; arow = PADF; brow = chunk * 128 + (t & 7) * 16; }
                    else if (t == 512) { arow = PADF; brow = NQKV; } else { arow = XR0 + 16 * (t - 513); brow = NQKV; }
                    accs[i] = thin16(XN + (size_t)(arow + (lane & 15)) * DM + 512 * F.wave + 8 * (lane >> 4), WIN + (size_t)(brow + (lane & 15)) * DM + 512 * F.wave + 8 * (lane >> 4), 16); } }
#pragma unroll
            for (int i = 0; i < 5; ++i) *(LAS f32x4*)(red + (i * 8 + F.wave) * 256 + lane * 4) = accs[i];
            __syncthreads();
            if (tid < 256) {
#pragma unroll
                for (int i = 0; i < 5; ++i) { const int t = (int)blockIdx.x + i * F.G;
                    if (t < NTASK) { float sum = 0.f;
#pragma unroll
                        for (int w = 0; w < 8; ++w) sum += red[(i * 8 + w) * 256 + tid];
                        int arow, brow; if (t < 512) { const int kc = t >> 3, chunk = kc < 32 ? 16 + kc : 32 + kc; arow = PADF; brow = chunk * 128 + (t & 7) * 16; }
                        else if (t == 512) { arow = PADF; brow = NQKV; } else { arow = XR0 + 16 * (t - 513); brow = NQKV; }
                        const int l = tid >> 2, tok = 4 * (l >> 4) + (tid & 3), col = l & 15;
                        sum *= pg8::rstd_of(SS1, arow + tok, RMS_EPS);
                        if (t < 512) PROJ[(size_t)(brow >> 7) * CH + (size_t)(arow + tok) * HD + (brow & 127) + col] = (bf16)f2bf(sum);
                        else LOGIT[(size_t)(arow + tok) * 16 + col] = sum; } }
            }
            __syncthreads();
            for (int i = blockIdx.x * 512 + tid; i < 64 * 48 * 16; i += F.G * 512) { const int kc = i / (48 * 16), r = i - kc * (48 * 16), chunk = kc < 32 ? 16 + kc : 32 + kc;
                *(GAS v4u*)(PROJ + (size_t)chunk * CH + (size_t)192 * HD + r * 8) = (v4u){0u, 0u, 0u, 0u}; }
        }
        if (BOTH(4)) GRID_BAR();
    }
    if (IN(5)) {
        const int tid = hidden_tid(), lane = tid & 63; (void)tid; (void)lane;
        const int b = blockIdx.x;
        const float NEGINF = -__builtin_inff();
        if (b < 16) {
            LAS double* ds = (LAS double*)(F.lds + RING_OFF);
            const float bf = args.in[8][b];
            float val[17]; double loc = 0.0;
            const int r0 = PADF + 17 * tid;
#pragma unroll
            for (int i = 0; i < 17; ++i) { const int r = r0 + i; float v = 0.f;
                if (r < MP) { const float xl = LOGIT[(size_t)r * 16 + b] + bf; v = fminf(xl, 0.f) - log1pf(expf(-fabsf(xl))); }
                val[i] = v; loc += (double)v; }
            ds[tid] = loc; __syncthreads();
#pragma unroll 1
            for (int o = 1; o < 512; o <<= 1) { double t = 0.0; if (tid >= o) t = ds[tid - o]; __syncthreads(); ds[tid] += t; __syncthreads(); }
            double run = tid > 0 ? ds[tid - 1] : 0.0;
            float* dst = BIAS + (size_t)(8 + b) * MP;
#pragma unroll
            for (int i = 0; i < 17; ++i) { const int r = r0 + i; run += (double)val[i]; if (r < MP) dst[r] = (float)(-run * (double)INV_SCALE); }
            for (int r = tid; r < PADF; r += 512) dst[r] = NEGINF;
            __syncthreads();
        } else if (b < 24) {
            const int h = b - 16; const float slope = exp2f(-(float)(h + 1));
            float* dst = BIAS + (size_t)h * MP;
            for (int r = tid; r < MP; r += 512) dst[r] = r < PADF ? NEGINF : slope * (float)r * INV_SCALE;
        }
        {
            const size_t CH = (size_t)MP * HD;
            for (int it = (int)blockIdx.x - 24; it >= 0 && it < 64 * 33; it += F.G - 24) {
                const int ci = it / 33, rt = it - ci * 33, chunk = ci < 32 ? ci : ci + 16;
                const bool isq = ci < 16 || (ci >= 32 && ci < 48);
                const int row = rt * 256 + (tid >> 1);
                float ss = 0.f;
                if (row >= (isq ? XR0 : PADF)) { const GAS v4u* p = (const GAS v4u*)(PROJ + (size_t)chunk * CH + (size_t)row * HD + (tid & 1) * 64);
#pragma unroll
                    for (int j = 0; j < 8; ++j) { const v4u w = p[j]; const float a0 = bf_lo(w.x), a1 = bf_hi(w.x), a2 = bf_lo(w.y), a3 = bf_hi(w.y), a4 = bf_lo(w.z), a5 = bf_hi(w.z), a6 = bf_lo(w.w), a7 = bf_hi(w.w);
                        ss += ((a0 * a0 + a1 * a1) + (a2 * a2 + a3 * a3)) + ((a4 * a4 + a5 * a5) + (a6 * a6 + a7 * a7)); } }
                ss += __shfl_xor(ss, 1);
#pragma unroll
                for (int o = 2; o < 64; o <<= 1) ss = fmaxf(ss, __shfl_xor(ss, o));
                if (lane == 0) __hip_atomic_fetch_max((unsigned*)(F.ctl + CW_NORM + chunk), __builtin_bit_cast(unsigned, ss), RLX_AGENT);
            }
        }
        if (BOTH(5)) GRID_BAR();
    }
    if (IN(6)) {
        const int tid = hidden_tid(), lane = tid & 63; (void)lane;
        char* al = (char*)lds + RING_OFF;
        const size_t CH = (size_t)MP * HD;
        volatile LAS int* MQ = (volatile LAS int*)(F.lds + MISC_OFF) + 16;
        const int home = blockIdx.x & 7;
#define QLEN(q_) ((4 + ((q_) < 4 ? 1 : 3)) * 32)
#define ATT_POP(dst_) do { int code_ = -1;                                                                                                 \
            for (int k_ = 0; k_ < 8; ++k_) { const int q_ = (home + k_) & 7;                                                               \
                const unsigned idx_ = __hip_atomic_fetch_add((unsigned*)(F.ctl + CW_QUEUE + 64 * q_), 1u, RLX_AGENT);                      \
                if (idx_ < (unsigned)QLEN(q_)) { code_ = q_ * 256 + (int)idx_; break; } }                                                  \
            dst_ = code_; } while (0)
#define ATT_REF(R_, code_) do { const int q_ = (code_) >> 8, i_ = (code_) & 255; int vh_, qb_;                                              \
            if (i_ < 128) { const int ii_ = i_ & 63, h_ = (i_ < 64) ? 4 + (q_ >> 1) : 3 - (q_ >> 1); vh_ = 4 * h_ + 2 * (q_ & 1) + (ii_ & 1); qb_ = 32 - (ii_ >> 1); } \
            else { const int ii_ = i_ - 128, nf_ = q_ < 4 ? 1 : 3, f_ = ii_ % nf_; qb_ = 32 - ii_ / nf_; vh_ = 32 + (q_ < 4 ? q_ : 4 + 3 * (q_ - 4) + f_); }  \
            int qc_, kc_, vc_, bi_; att::bf16* ob_;                                                                                         \
            if (vh_ < 32) { const int h_ = vh_ >> 2, c_ = (vh_ >> 1) & 1, hf_ = vh_ & 1; qc_ = 2 * h_ + c_; kc_ = 16 + 2 * h_ + c_; vc_ = 32 + 2 * h_ + hf_; bi_ = h_; \
                            ob_ = (c_ ? O1B : OB) + h_ * 256 + hf_ * 128; }                                                                \
            else { const int h_ = vh_ - 32; qc_ = 48 + h_; kc_ = 64 + h_; vc_ = 80 + h_; bi_ = 8 + h_; ob_ = OB + 2048 + h_ * 128; }        \
            R_.Q = PROJ + (size_t)qc_ * CH + (size_t)qb_ * 256 * HD; R_.K = PROJ + (size_t)kc_ * CH; R_.V = PROJ + (size_t)vc_ * CH;        \
            R_.O = ob_ + (size_t)qb_ * 256 * DM; R_.P0 = qb_ * 256;                                                                         \
            const float* bt_ = BIAS + (size_t)bi_ * MP;                                                                                     \
            const float qn_ = __builtin_bit_cast(float, __hip_atomic_load((unsigned*)(F.ctl + CW_NORM + qc_), RLX_AGENT));                   \
            const float kn_ = __builtin_bit_cast(float, __hip_atomic_load((unsigned*)(F.ctl + CW_NORM + kc_), RLX_AGENT));                   \
            const float c0_ = 2.0f * sqrtf(qn_ * kn_) * 1.002f - bt_[R_.P0];                                                               \
            const int ln_ = hidden_tid() & 63, j1_ = 3 + ln_, j2_ = 67 + ln_, je_ = 4 * qb_;                                                                       \
            const bool ns1_ = j1_ < je_ ? !((c0_ + bt_[64 * j1_ + 63]) * (att::SCALE * 1.4426950408889634f) < -160.0f) : true;              \
            const bool ns2_ = j2_ < je_ ? !((c0_ + bt_[64 * j2_ + 63]) * (att::SCALE * 1.4426950408889634f) < -160.0f) : true;              \
            const unsigned long long m1_ = __ballot(ns1_), m2_ = __ballot(ns2_);                                                            \
            int jl_ = m1_ ? 3 + __builtin_ctzll(m1_) : (m2_ ? 67 + __builtin_ctzll(m2_) : je_); if (jl_ > je_) jl_ = je_;                  \
            R_.jlo = __builtin_amdgcn_readfirstlane(jl_); R_##_bias = bt_; } while (0)
#define ATT_BIAS(R_) do { for (int i_ = 16 * R_.jlo + tid; i_ < (R_.P0 + 256) / 4; i_ += 512) *(f32x4*)(al + att::BIAS_OFF + 16 * i_) = *(const f32x4*)(R_##_bias + 4 * i_); } while (0)
        if (tid == 0) { int c0, c1; ATT_POP(c0); if (c0 >= 0) ATT_POP(c1); else c1 = -1; MQ[0] = c0; MQ[2] = c1; }
        __syncthreads();
        const int c_first = MQ[0]; int c_nxt = MQ[2];
        if (c_first >= 0) {
            att::Seam S; att::BlockRef cur, nxt; const float* cur_bias; const float* nxt_bias;
            ATT_REF(cur, c_first);
            ATT_BIAS(cur);
            att::attn_prime(cur, al, S);
            for (;;) {
                const bool last = c_nxt < 0;
                if (!last) ATT_REF(nxt, c_nxt); else { nxt = cur; nxt_bias = cur_bias; }
                if (tid == 0) { int c2 = -1; if (!last) ATT_POP(c2); MQ[0] = c2; }
                att::attn_block(cur, nxt, al, S);
                if (last) break;
                cur = nxt; cur_bias = nxt_bias; c_nxt = MQ[0];
                ATT_BIAS(cur); __syncthreads();
            }
        }
#undef QLEN
#undef ATT_POP
#undef ATT_REF
#undef ATT_BIAS
        if (BOTH(6)) GRID_BAR();
    }
    if (IN(7)) {
        const int tid = hidden_tid(), lane = tid & 63; (void)tid; (void)lane;
        float lam;
        { const float* q1 = args.in[9]; const float* k1 = args.in[10]; const float* q2 = args.in[11]; const float* k2 = args.in[12];
          const float s1 = wave_sum(q1[lane] * k1[lane] + q1[lane + 64] * k1[lane + 64]);
          const float s2 = wave_sum(q2[lane] * k2[lane] + q2[lane + 64] * k2[lane + 64]);
          lam = expf(s1) - expf(s2) + LAMBDA_INIT; }
        const f32x4 gn = *(const f32x4*)(args.in[13] + 4 * lane);
        for (int m = XR0 + gw; m < MP; m += NGW) {
            GAS v2u* o0 = (GAS v2u*)(OB + (size_t)m * DM) + lane; const GAS v2u* o1 = (const GAS v2u*)(O1B + (size_t)m * DM) + lane;
            v2u a[8], c[8];
#pragma unroll
            for (int h = 0; h < 8; ++h) { a[h] = o0[64 * h]; c[h] = o1[64 * h]; }
#pragma unroll
            for (int h = 0; h < 8; ++h) {
                const float x0 = bf_lo(a[h].x) - lam * bf_lo(c[h].x), x1 = bf_hi(a[h].x) - lam * bf_hi(c[h].x), x2 = bf_lo(a[h].y) - lam * bf_lo(c[h].y), x3 = bf_hi(a[h].y) - lam * bf_hi(c[h].y);
                const float ss = wave_sum((x0 * x0 + x1 * x1) + (x2 * x2 + x3 * x3));
                const float r = 1.0f / sqrtf(ss * (1.0f / 256.0f) + SUBLN_EPS);
                v2u w; w.x = pk2(x0 * r * gn.x * (1.0f - LAMBDA_INIT), x1 * r * gn.y * (1.0f - LAMBDA_INIT)); w.y = pk2(x2 * r * gn.z * (1.0f - LAMBDA_INIT), x3 * r * gn.w * (1.0f - LAMBDA_INIT));
                o0[64 * h] = w; }
        }
        if (BOTH(7)) GRID_BAR();
    }
    if (IN(8)) {
        pg8::Gemm g{OB + (size_t)XR0 * DM, WOUT, SEQ, DM, DM}; pg8::StaticOrder S; S.init(SEQ, DM, F.G, (int)blockIdx.x);
        pg8::EpiResid<true> E{H, 0, H, DM, 1.0f, XR0, XN, SS2};
        pg8::gemm_phase<pg8::EpiResid<true>, pg8::StaticOrder, true, true>(F.lds + RING_OFF, g, S, E);
        if (BOTH(8)) GRID_BAR();
    }
    if (IN(10)) {
        pg8::Gemm g{XN + (size_t)XR0 * DM, W2GU, SEQ, NGU, DM}; pg8::StaticOrder S; S.init(SEQ, NGU, F.G, (int)blockIdx.x);
        pg8::EpiSwiGLU E{ACT, DFF, XR0, SS2};
        pg8::gemm_phase<pg8::EpiSwiGLU, pg8::StaticOrder, true, true>(F.lds + RING_OFF, g, S, E);
        if (BOTH(10)) GRID_BAR();
    }
    if (IN(11)) {
        pg8::Gemm g{ACT + (size_t)XR0 * DFF, W2D, SEQ, DM, DFF}; pg8::StaticOrder S; S.init(SEQ, DM, F.G, (int)blockIdx.x);
        pg8::EpiResid<false> E{H, 0, H, DM, 0.5f, XR0, nullptr, nullptr};
        pg8::gemm_phase<pg8::EpiResid<false>, pg8::StaticOrder, true, true>(F.lds + RING_OFF, g, S, E);
        if (BOTH(11)) GRID_BAR();
    }
    if (IN(12)) {
        const int tid = hidden_tid(), lane = tid & 63; (void)tid;
        const GAS f32x4* gr = (const GAS f32x4*)args.in[19] + lane;
        f32x4 gg[16];
#pragma unroll
        for (int j = 0; j < 16; ++j) gg[j] = gr[64 * j];
#define P12_LOAD(V_, m_) do { const GAS f32x4* xr_ = (const GAS f32x4*)(H + (size_t)(m_) * DM) + lane; _Pragma("unroll") for (int j = 0; j < 16; ++j) V_[j] = __builtin_nontemporal_load(xr_ + 64 * j); } while (0)
#define P12_STORE(V_, m_) do { float s_ = 0.f; _Pragma("unroll") for (int j = 0; j < 16; ++j) s_ += (V_[j].x * V_[j].x + V_[j].y * V_[j].y) + (V_[j].z * V_[j].z + V_[j].w * V_[j].w);   \
            const float r_ = 1.0f / sqrtf(wave_sum(s_) * (1.0f / DM) + RMS_EPS); GAS f32x4* o_ = (GAS f32x4*)(args.out + (size_t)((m_) - XR0) * DM) + lane;                      \
            _Pragma("unroll") for (int j = 0; j < 16; ++j) { f32x4 w_; w_.x = V_[j].x * r_ * gg[j].x; w_.y = V_[j].y * r_ * gg[j].y; w_.z = V_[j].z * r_ * gg[j].z; w_.w = V_[j].w * r_ * gg[j].w; \
                __builtin_nontemporal_store(w_, o_ + 64 * j); } } while (0)
        f32x4 va[16], vb[16];
        int m = XR0 + gw;
        if (m < MP) {
            P12_LOAD(va, m);
            for (;;) {
                const int mn = m + NGW;
                if (mn < MP) P12_LOAD(vb, mn);
                P12_STORE(va, m);
                if (mn >= MP) break;
                const int m2 = mn + NGW;
                if (m2 < MP) P12_LOAD(va, m2);
                P12_STORE(vb, mn);
                if (m2 >= MP) break;
                m = m2;
            }
        }
#undef P12_LOAD
#undef P12_STORE
    }
#undef IN
#undef BOTH
#undef GRID_BAR
}

extern "C" void kernel_launch(void* const* d_in, const int* in_sizes, int n_in, void* d_out, int out_size, void* d_ws, size_t ws_size, hipStream_t stream) {
    static int grid = 0;
    if (grid == 0) {
        if (n_in != 20 || in_sizes[0] != SEQ * DM || out_size != SEQ * DM || ws_size < WS_END) { fprintf(stderr, "kernel_launch: shape / workspace mismatch: n_in %d in0 %d out %d ws %zu (need %zu)\n", n_in, n_in > 0 ? in_sizes[0] : -1, out_size, ws_size, (size_t)WS_END); grid = -1; return; }
        int dev = 0, cus = 0, per_cu = 0;
        if (hipGetDevice(&dev) != hipSuccess || hipDeviceGetAttribute(&cus, hipDeviceAttributeMultiprocessorCount, dev) != hipSuccess) { grid = -1; return; }
        if (hipFuncSetAttribute((const void*)hymba_fwd, hipFuncAttributeMaxDynamicSharedMemorySize, LDS_BYTES) != hipSuccess) { fprintf(stderr, "kernel_launch: hipFuncSetAttribute failed\n"); grid = -1; return; }
        if (hipOccupancyMaxActiveBlocksPerMultiprocessor(&per_cu, (const void*)hymba_fwd, NWAVES * 64, LDS_BYTES) != hipSuccess || per_cu < 1) { fprintf(stderr, "kernel_launch: occupancy query reports %d\n", per_cu); }
        (void)hipGetLastError();
        grid = cus;
        if (grid * 5 < 513 + SEQ / 16 || grid % 8 != 0) { fprintf(stderr, "kernel_launch: built for a 256-CU device (grid %d)\n", grid); grid = -1; return; }
    }
    if (grid < 0) return;
    if (hipMemsetAsync((char*)d_ws + WS_CTL, 0, CTL_ZERO_BYTES, stream) != hipSuccess) return;
    Args a{};
    for (int i = 0; i < 20; ++i) a.in[i] = (const float*)d_in[i];
    a.out = (float*)d_out; a.ws = (unsigned char*)d_ws;
#if defined(PROBE_PHASE)
    a.ph_lo = 0; a.ph_hi = PROBE_PHASE + 1; hipLaunchKernelGGL(hymba_fwd, dim3(grid), dim3(NWAVES * 64), LDS_BYTES, stream, a);
    if (hipMemsetAsync((char*)d_ws + WS_CTL + CW_BAR * 4, 0, (CW_QUEUE + 8 * 64 - CW_BAR) * 4, stream) != hipSuccess) return;
    a.ph_lo = PROBE_PHASE; a.ph_hi = N_PHASES; hipLaunchKernelGGL(hymba_fwd, dim3(grid), dim3(NWAVES * 64), LDS_BYTES, stream, a);
#else
    if (N_LAUNCHES == 1) { a.ph_lo = 0; a.ph_hi = N_PHASES; hipLaunchKernelGGL(hymba_fwd, dim3(grid), dim3(NWAVES * 64), LDS_BYTES, stream, a); }
    else for (int p = 0; p < N_PHASES; ++p) { a.ph_lo = p; a.ph_hi = p + 1; hipLaunchKernelGGL(hymba_fwd, dim3(grid), dim3(NWAVES * 64), LDS_BYTES, stream, a); }
#endif
}
```

```cpp
#include <hip/hip_runtime.h>
#include <cstdio>
#include <cstdint>
#ifndef MK_N_LAUNCHES
#define MK_N_LAUNCHES 1
#endif
namespace pg8 {
#define PG8_LAS __attribute__((address_space(3)))
typedef unsigned short bf16_t;
typedef short bf16x8 __attribute__((ext_vector_type(8)));
typedef float f32x4 __attribute__((ext_vector_type(4)));
typedef unsigned u32x4 __attribute__((ext_vector_type(4)));
constexpr int BM = 256, BK = 64, HALF = 128, HTB = HALF * BK * 2  , STAGE_BYTES = 8 * HTB, NXCD = 8, WGM = 8;

__host__ __device__ __forceinline__ int lds_byte(int r, int c) { const int st = (r >> 4) * 2 + (c >> 5), rr = r & 15, cc = c & 31, ob = rr * 64 + cc * 2; return st * 1024 + (ob ^ (((ob >> 9) & 1) << 5)); }
__host__ __device__ __forceinline__ void stage_rc(int b, int& R, int& C) { const int st = b / 1024, sb = b % 1024, swz = sb ^ (((sb >> 9) & 1) << 5); R = (st >> 1) * 16 + swz / 64; C = (st & 1) * 32 + (swz % 64) / 2; }
__host__ __device__ __forceinline__ int perm32(int rho) { const int n = rho >> 4, i = rho & 15; return 8 * (i >> 2) + 4 * n + (i & 3); }

struct Unit { int pm, pn; };
struct Gemm { const bf16_t* A; const bf16_t* Bt; int M, N, K; };

struct StaticOrder {
    int nM, nN, nwg, G, c;
    __host__ __device__ void init(int M, int N, int G_, int c_) { nM = M / BM; nN = N / BM; nwg = nM * nN; G = G_; c = c_; }
    __host__ __device__ bool next(int i, Unit& u) const {
        const long L = (long)i * G + c; if (L >= nwg) return false;
        int wgid = (int)L; { const int q = nwg / NXCD, r = nwg % NXCD, xcd = wgid % NXCD, off = wgid / NXCD; wgid = (xcd < r ? xcd * (q + 1) : r * (q + 1) + (xcd - r) * q) + off; }
        const int nig = WGM * nN, gid = wgid / nig, fm = gid * WGM, gsz = (nM - fm) < WGM ? (nM - fm) : WGM;
        u.pm = fm + ((wgid % nig) % gsz); u.pn = (wgid % nig) / gsz; return true;
    }
    __device__ __forceinline__ void a_ready(const Unit&) const {}
    __device__ __forceinline__ void done(const Unit&) const {}
};

__device__ __forceinline__ unsigned cvt_pk_bf16(float lo, float hi) { unsigned r; asm volatile("v_cvt_pk_bf16_f32 %0, %1, %2" : "=v"(r) : "v"(lo), "v"(hi)); return r; }
__device__ __forceinline__ float silu_mul(float g, float u) { const float e = __builtin_amdgcn_exp2f(g * -1.4426950408889634f); return g * __builtin_amdgcn_rcpf(1.0f + e) * u; }

__device__ __forceinline__ float rstd_of(const unsigned long long* ss, int row, float eps) {
    const unsigned long long v = ss[row];
    return 1.0f / sqrtf((float)v * (1.0f / (16777216.0f * 4096.0f)) + eps);
}
__device__ __forceinline__ float rstd_from(unsigned long long v, float eps) { return 1.0f / sqrtf((float)v * (1.0f / (16777216.0f * 4096.0f)) + eps); }
struct EpiSwiGLU {
    static constexpr bool PERM = true, AFTER_DRAIN = false;
    bf16_t* O; int ldc; int row_off; const unsigned long long* ss;
    __device__ __forceinline__ void operator()(const f32x4 (&acc)[2][2][4][2], const Unit& u, int wr, int wc, int fr, int fq) const {
        const int row0 = row_off + u.pm * BM + wr * 64 + fr, col0 = u.pn * HALF + wc * 32 + 8 * fq;
        unsigned long long sv[2][4];
#pragma unroll
        for (int ai = 0; ai < 2; ++ai)
#pragma unroll
            for (int m = 0; m < 4; ++m) sv[ai][m] = ss[row0 + ai * HALF + m * 16];
#pragma unroll
        for (int ai = 0; ai < 2; ++ai)
#pragma unroll
            for (int m = 0; m < 4; ++m) { bf16_t* rowp = O + (size_t)(row0 + ai * HALF + m * 16) * ldc + col0;
                const float rs = rstd_from(sv[ai][m], 1e-6f);
                const f32x4 g0 = acc[ai][0][m][0] * rs, g1 = acc[ai][0][m][1] * rs, u0 = acc[ai][1][m][0] * rs, u1 = acc[ai][1][m][1] * rs;
                u32x4 w; w.x = cvt_pk_bf16(silu_mul(g0[0], u0[0]), silu_mul(g0[1], u0[1])); w.y = cvt_pk_bf16(silu_mul(g0[2], u0[2]), silu_mul(g0[3], u0[3]));
                w.z = cvt_pk_bf16(silu_mul(g1[0], u1[0]), silu_mul(g1[1], u1[1])); w.w = cvt_pk_bf16(silu_mul(g1[2], u1[2]), silu_mul(g1[3], u1[3]));
                *(u32x4*)rowp = w; }
    }
};
template <bool XN> struct EpiResid {
    static constexpr bool PERM = false, AFTER_DRAIN = false;
    const float* base; int shift; float* out; int ldc; float alpha; int row_off; bf16_t* xn; unsigned long long* ssout;
    __device__ __forceinline__ void operator()(const f32x4 (&acc)[2][2][4][2], const Unit& u, int wr, int wc, int fr, int fq) const {
        typedef unsigned u32x2v __attribute__((ext_vector_type(2)));
        const int row0 = row_off + u.pm * BM + wr * 64 + fr, col0 = u.pn * BM + wc * 32 + 4 * fq;
#pragma unroll
        for (int ai = 0; ai < 2; ++ai) {
            f32x4 b[4][2][2];
#pragma unroll
            for (int m = 0; m < 4; ++m) { const float* brow = base + (size_t)(row0 + ai * HALF + m * 16 - shift) * ldc + col0;
#pragma unroll
                for (int bj = 0; bj < 2; ++bj)
#pragma unroll
                    for (int n = 0; n < 2; ++n) b[m][bj][n] = *(const f32x4*)(brow + bj * HALF + n * 16); }
#pragma unroll
            for (int m = 0; m < 4; ++m) { const int r = row0 + ai * HALF + m * 16; float* orow = out + (size_t)r * ldc + col0; float sq = 0.f;
#pragma unroll
                for (int bj = 0; bj < 2; ++bj)
#pragma unroll
                    for (int n = 0; n < 2; ++n) { const f32x4 o = b[m][bj][n] + acc[ai][bj][m][n] * alpha; *(f32x4*)(orow + bj * HALF + n * 16) = o;
                        if (XN) { u32x2v w; w.x = cvt_pk_bf16(o[0], o[1]); w.y = cvt_pk_bf16(o[2], o[3]); *(u32x2v*)(xn + (size_t)r * ldc + col0 + bj * HALF + n * 16) = w;
                            sq += (o[0] * o[0] + o[1] * o[1]) + (o[2] * o[2] + o[3] * o[3]); } }
                if (XN) { sq += __shfl_xor(sq, 16); sq += __shfl_xor(sq, 32);
                    if (fq == 0) __hip_atomic_fetch_add(ssout + r, (unsigned long long)(sq * 16777216.0f), __ATOMIC_RELAXED, __HIP_MEMORY_SCOPE_AGENT); } }
        }
    }
};
struct EpiProj {
    static constexpr bool PERM = true, AFTER_DRAIN = false;
    bf16_t* P; size_t chunk_stride; float* logit; int row_off; const unsigned long long* ss;
    __device__ __forceinline__ void operator()(const f32x4 (&acc)[2][2][4][2], const Unit& u, int wr, int wc, int fr, int fq) const {
        const int row0 = row_off + u.pm * BM + wr * 64 + fr;
        if (u.pn < 48) {
            unsigned long long sv[2][4];
#pragma unroll
            for (int ai = 0; ai < 2; ++ai)
#pragma unroll
                for (int m = 0; m < 4; ++m) sv[ai][m] = ss[row0 + ai * HALF + m * 16];
#pragma unroll
            for (int ai = 0; ai < 2; ++ai)
#pragma unroll
                for (int m = 0; m < 4; ++m) { const int r = row0 + ai * HALF + m * 16; const float rs = rstd_from(sv[ai][m], 1e-6f);
#pragma unroll
                    for (int bj = 0; bj < 2; ++bj) { bf16_t* dst = P + (size_t)(2 * u.pn + bj) * chunk_stride + (size_t)r * 128 + wc * 32 + 8 * fq;
                        const f32x4 v0 = acc[ai][bj][m][0] * rs, v1 = acc[ai][bj][m][1] * rs;
                        u32x4 w; w.x = cvt_pk_bf16(v0[0], v0[1]); w.y = cvt_pk_bf16(v0[2], v0[3]); w.z = cvt_pk_bf16(v1[0], v1[1]); w.w = cvt_pk_bf16(v1[2], v1[3]);
                        *(u32x4*)dst = w; } }
        } else if (wc == 0 && fq < 2) {
#pragma unroll
            for (int ai = 0; ai < 2; ++ai)
#pragma unroll
                for (int m = 0; m < 4; ++m) { const int r = row0 + ai * HALF + m * 16;
#pragma unroll
                    for (int n = 0; n < 2; ++n) *(f32x4*)(logit + (size_t)r * 16 + 8 * fq + 4 * n) = acc[ai][0][m][n]; }
        }
    }
};
template <class Epi, class Sched, bool ALIGN_EPI = false, bool SP2 = false>
__device__ __forceinline__ void gemm_phase(PG8_LAS unsigned char* lds, const Gemm g, const Sched& S, const Epi& E) {
    const int tid = threadIdx.x, wid = __builtin_amdgcn_readfirstlane(tid >> 6), lane = tid & 63, wr = wid >> 2, wc = wid & 3, fr = lane & 15, fq = lane >> 4;
    const int K = g.K, nt = K / BK;
    unsigned voffA[2], voffB[2];
#pragma unroll
    for (int i = 0; i < 2; ++i) { int R, C; stage_rc(tid * 16 + i * 8192, R, C); const int Rb = Epi::PERM ? ((R & ~31) + perm32(R & 31)) : R;
        voffA[i] = (unsigned)(R * K + C) * 2u; voffB[i] = (unsigned)(Rb * K + C) * 2u; }
    const size_t kstep = (size_t)(BK * 2);
    const size_t hstep = (size_t)HALF * K * 2;
    const size_t tstep = 2 * hstep;
    const unsigned ldsw = (unsigned)wid * 1024u;
    const int aoff = lds_byte(wr * 64 + fr, fq * 8), boff = lds_byte(wc * 32 + fr, fq * 8);
#define PG8_SA(b, h) (((b) * 2 + (h)) * HTB)
#define PG8_SB(b, h) ((4 + (b) * 2 + (h)) * HTB)
#define PG8_STAGE(bufoff, gbase, voff) do { _Pragma("unroll") for (int _i = 0; _i < 2; ++_i) \
        __builtin_amdgcn_global_load_lds((const unsigned*)((const char*)(gbase) + (voff)[_i]), (PG8_LAS unsigned*)(lds + (bufoff) + ldsw + _i * 8192), 16, 0, 0); } while (0)
#define PG8_LDA(dst, b, h) do { _Pragma("unroll") for (int m = 0; m < 4; ++m) _Pragma("unroll") for (int k = 0; k < 2; ++k) dst[m][k] = *(const PG8_LAS bf16x8*)(lds + PG8_SA(b, h) + aoff + m * 2048 + k * 1024); } while (0)
#define PG8_LDB(dst, b, h) do { _Pragma("unroll") for (int n = 0; n < 2; ++n) _Pragma("unroll") for (int k = 0; k < 2; ++k) dst[n][k] = *(const PG8_LAS bf16x8*)(lds + PG8_SB(b, h) + boff + n * 2048 + k * 1024); } while (0)
#define PG8_MMA(ai, bj, At, Bt) do { __builtin_amdgcn_s_setprio(1); _Pragma("unroll") for (int m = 0; m < 4; ++m) _Pragma("unroll") for (int n = 0; n < 2; ++n) _Pragma("unroll") for (int k = 0; k < 2; ++k) \
        acc[ai][bj][m][n] = __builtin_amdgcn_mfma_f32_16x16x32_bf16(Bt[n][k], At[m][k], acc[ai][bj][m][n], 0, 0, 0); __builtin_amdgcn_s_setprio(0); } while (0)
#define PG8_WAIT_V(n) asm volatile("s_waitcnt vmcnt(" #n ")" ::: "memory")
#define PG8_WAIT_L(n) asm volatile("s_waitcnt lgkmcnt(" #n ")" ::: "memory")
#define PG8_BAR __builtin_amdgcn_s_barrier()
#define PG8_SCHED __builtin_amdgcn_sched_barrier(0)
    Unit cur, nxt; int ui = 0;
    if (!S.next(0, cur)) return;
    f32x4 acc[2][2][4][2];
#pragma unroll
    for (int a = 0; a < 2; ++a)
#pragma unroll
        for (int b = 0; b < 2; ++b)
#pragma unroll
            for (int m = 0; m < 4; ++m)
#pragma unroll
                for (int n = 0; n < 2; ++n) acc[a][b][m][n] = (f32x4){0.f, 0.f, 0.f, 0.f};
    bf16x8 At[4][2], B0[2][2], B1[2][2];
    const char* cA = (const char*)g.A + (size_t)cur.pm * tstep; const char* cB = (const char*)g.Bt + (size_t)cur.pn * tstep;
    S.a_ready(cur);
    if constexpr (SP2) {
        PG8_STAGE(PG8_SB(0, 0), cB, voffB); PG8_STAGE(PG8_SB(0, 1), cB + hstep, voffB); PG8_STAGE(PG8_SA(0, 0), cA, voffA); PG8_STAGE(PG8_SA(0, 1), cA + hstep, voffA);
        if (wr == 1) PG8_BAR;
        PG8_WAIT_V(2); PG8_BAR;
        PG8_STAGE(PG8_SB(1, 0), cB + kstep, voffB); PG8_STAGE(PG8_SA(1, 0), cA + kstep, voffA); PG8_STAGE(PG8_SB(1, 1), cB + hstep + kstep, voffB);
        PG8_WAIT_V(6); PG8_BAR;
    } else {
        PG8_STAGE(PG8_SB(0, 0), cB, voffB); PG8_STAGE(PG8_SA(0, 0), cA, voffA); PG8_STAGE(PG8_SB(0, 1), cB + hstep, voffB); PG8_STAGE(PG8_SA(0, 1), cA + hstep, voffA);
        if (wr == 1) PG8_BAR;
        PG8_WAIT_V(4); PG8_BAR;
        PG8_STAGE(PG8_SB(1, 0), cB + kstep, voffB); PG8_STAGE(PG8_SA(1, 0), cA + kstep, voffA); PG8_STAGE(PG8_SB(1, 1), cB + hstep + kstep, voffB);
        PG8_WAIT_V(6); PG8_BAR;
    }
    for (;;) {
        const bool has_next = S.next(ui + 1, nxt);
        const char* nA = has_next ? (const char*)g.A + (size_t)nxt.pm * tstep : cA; const char* nB = has_next ? (const char*)g.Bt + (size_t)nxt.pn * tstep : cB;
        for (int t = 0; t < nt; t += 2) {
            const bool last = (t == nt - 2);
            const char* a1 = cA + (size_t)(t + 1) * kstep;
            const char* a2 = last ? nA : cA + (size_t)(t + 2) * kstep; const char* b2 = last ? nB : cB + (size_t)(t + 2) * kstep;
            const char* a3 = a2 + kstep; const char* b3 = b2 + kstep;
            if (last && has_next) S.a_ready(nxt);
            if constexpr (SP2) {
            PG8_LDB(B0, 0, 0); PG8_LDB(B1, 0, 1); PG8_SCHED; PG8_LDA(At, 0, 0); PG8_STAGE(PG8_SA(1, 1), a1 + hstep, voffA);
            PG8_WAIT_V(8); PG8_WAIT_L(0); PG8_BAR; PG8_MMA(0, 0, At, B0); PG8_MMA(0, 1, At, B1); PG8_BAR; PG8_SCHED;
            PG8_LDA(At, 0, 1); PG8_STAGE(PG8_SB(0, 0), b2, voffB); PG8_STAGE(PG8_SB(0, 1), b2 + hstep, voffB); PG8_STAGE(PG8_SA(0, 0), a2, voffA);
            PG8_WAIT_V(8); PG8_WAIT_L(0); PG8_BAR; PG8_MMA(1, 0, At, B0); PG8_MMA(1, 1, At, B1); PG8_BAR; PG8_SCHED;
            PG8_LDB(B0, 1, 0); PG8_LDB(B1, 1, 1); PG8_SCHED; PG8_LDA(At, 1, 0); PG8_STAGE(PG8_SA(0, 1), a2 + hstep, voffA);
            PG8_WAIT_V(8); PG8_WAIT_L(0); PG8_BAR; PG8_MMA(0, 0, At, B0); PG8_MMA(0, 1, At, B1); PG8_BAR; PG8_SCHED;
            PG8_LDA(At, 1, 1); PG8_STAGE(PG8_SB(1, 0), b3, voffB); PG8_STAGE(PG8_SB(1, 1), b3 + hstep, voffB); PG8_STAGE(PG8_SA(1, 0), a3, voffA);
            PG8_WAIT_V(8); PG8_WAIT_L(0); PG8_BAR; PG8_MMA(1, 0, At, B0); PG8_MMA(1, 1, At, B1); PG8_BAR; PG8_SCHED;
            } else {
            PG8_LDB(B0, 0, 0); PG8_SCHED; PG8_LDA(At, 0, 0); PG8_STAGE(PG8_SA(1, 1), a1 + hstep, voffA);
            PG8_WAIT_L(8); PG8_BAR; PG8_WAIT_L(0); PG8_MMA(0, 0, At, B0); PG8_BAR; PG8_SCHED;
            PG8_LDB(B1, 0, 1); PG8_STAGE(PG8_SB(0, 0), b2, voffB);
            PG8_BAR; PG8_WAIT_L(0); PG8_MMA(0, 1, At, B1); PG8_BAR;
            PG8_LDA(At, 0, 1); PG8_STAGE(PG8_SA(0, 0), a2, voffA);
            PG8_BAR; PG8_WAIT_L(0); PG8_MMA(1, 0, At, B0); PG8_BAR; PG8_SCHED;
            PG8_STAGE(PG8_SB(0, 1), b2 + hstep, voffB);
            PG8_WAIT_V(6); PG8_BAR; PG8_MMA(1, 1, At, B1); PG8_BAR;
            PG8_LDB(B0, 1, 0); PG8_SCHED; PG8_LDA(At, 1, 0); PG8_STAGE(PG8_SA(0, 1), a2 + hstep, voffA);
            PG8_WAIT_L(8); PG8_BAR; PG8_WAIT_L(0); PG8_MMA(0, 0, At, B0); PG8_BAR; PG8_SCHED;
            PG8_LDB(B1, 1, 1); PG8_STAGE(PG8_SB(1, 0), b3, voffB);
            PG8_BAR; PG8_WAIT_L(0); PG8_MMA(0, 1, At, B1); PG8_BAR;
            PG8_LDA(At, 1, 1); PG8_STAGE(PG8_SA(1, 0), a3, voffA);
            PG8_BAR; PG8_WAIT_L(0); PG8_MMA(1, 0, At, B0); PG8_BAR; PG8_SCHED;
            PG8_STAGE(PG8_SB(1, 1), b3 + hstep, voffB);
            PG8_WAIT_V(6); PG8_BAR; PG8_MMA(1, 1, At, B1); PG8_BAR;
            }
        }
        if constexpr (ALIGN_EPI) { if (wr == 0) PG8_BAR; }
        if constexpr (!Epi::AFTER_DRAIN) { E(acc, cur, wr, wc, fr, fq); S.done(cur); }
        if (!has_next) break;
#pragma unroll
        for (int a = 0; a < 2; ++a)
#pragma unroll
            for (int b = 0; b < 2; ++b)
#pragma unroll
                for (int m = 0; m < 4; ++m)
#pragma unroll
                    for (int n = 0; n < 2; ++n) acc[a][b][m][n] = (f32x4){0.f, 0.f, 0.f, 0.f};
        cur = nxt; cA = nA; cB = nB; ++ui;
        if constexpr (ALIGN_EPI) { if (wr == 1) PG8_BAR; }
    }
    PG8_WAIT_V(0);
    if constexpr (!ALIGN_EPI) { if (wr == 0) PG8_BAR; }
    PG8_BAR;
    if constexpr (Epi::AFTER_DRAIN) { E.fused(acc, cur, wr, wc, fr, fq, lds, wid, lane); S.done(cur); }
#undef PG8_SA
#undef PG8_SB
#undef PG8_STAGE
#undef PG8_LDA
#undef PG8_LDB
#undef PG8_MMA
#undef PG8_WAIT_V
#undef PG8_WAIT_L
#undef PG8_BAR
#undef PG8_SCHED
}
}

namespace att {
typedef unsigned short bf16;
typedef short bf16x8 __attribute__((ext_vector_type(8)));
typedef short s16x4 __attribute__((ext_vector_type(4)));
typedef float f32x16 __attribute__((ext_vector_type(16)));
typedef float f32x4 __attribute__((ext_vector_type(4)));
typedef unsigned u32x4 __attribute__((ext_vector_type(4)));
constexpr int D = 128;
constexpr float SCALE = 0.08838834764831845f;
constexpr float THR = 8.f;
constexpr int NW = 8, QBLK = 32, KVBLK = 64, QB = NW * QBLK;
constexpr int SHM_V = KVBLK * D * 2, SHM_K = KVBLK * D * 2;
constexpr int WS_OFF = 2 * SHM_V + 2 * SHM_K;
constexpr int BIAS_OFF = WS_OFF + NW * 64 * 4;
constexpr int BIAS_N = 8448;
constexpr int ATT_LDS_BYTES = BIAS_OFF + BIAS_N * 4;
constexpr int J_LO = 3;
constexpr unsigned WBIG = 1u << 30;
constexpr int OP = 4096;

#define KSWZ(row, colB) ((row) * 256 + ((colB) ^ (((row) & 7) << 4)))
#define SBAR() __builtin_amdgcn_sched_barrier(0)
__device__ __forceinline__ int v_st(int k, int c) { const int kk = (k & ~0xC) | ((k & 4) << 1) | ((k & 8) >> 1); return ((kk >> 3) * 4 + (c >> 5)) * 512 + ((kk & 7) * 32 + (c & 31)) * 2; }
__device__ __forceinline__ int v_rd_base(int lane) { return ((lane & 3) << 3) | (((lane >> 2) & 3) << 6) | (((lane >> 4) & 1) << 5) | (((lane >> 5) & 1) << 8); }
constexpr int v_rd_off(int d0, int ks, int half) { return d0 * 512 + ks * 4096 + half * 2048; }
__device__ __forceinline__ int crow(int r, int hi) { return (r & 3) + 8 * (r >> 2) + 4 * hi; }
__device__ __forceinline__ unsigned cvtpk(float lo, float hi) { unsigned r; asm volatile("v_cvt_pk_bf16_f32 %0, %1, %2" : "=v"(r) : "v"(lo), "v"(hi)); return r; }
__device__ __forceinline__ bf16x8 load8(const bf16* p) { return *reinterpret_cast<const bf16x8*>(p); }
__device__ __forceinline__ void mask_tile(f32x16& p0, f32x16& p1, int dq, unsigned W) {
    const float NEG = -__builtin_inff();
#pragma unroll
    for (int r = 0; r < 16; ++r) {
        const int c = (r & 3) + 8 * (r >> 2);
        if ((unsigned)(dq - c) >= W) p0[r] = NEG;
        if ((unsigned)(dq - c - 32) >= W) p1[r] = NEG;
    }
}
__device__ __forceinline__ void partialSM(f32x16& p0, f32x16& p1, float& m_reg, float& mn, float& alpha) {
    float pmax = p0[0]; for (int r = 1; r < 16; ++r) pmax = fmaxf(pmax, p0[r]); for (int r = 0; r < 16; ++r) pmax = fmaxf(pmax, p1[r]);
    { auto rr = __builtin_amdgcn_permlane32_swap(__float_as_uint(pmax), __float_as_uint(pmax), false, false);
      pmax = fmaxf(__uint_as_float(rr[0]), __uint_as_float(rr[1])); }
    constexpr float C2 = 1.4426950408889634f * SCALE;
    if (__builtin_expect(__all((pmax - m_reg) * SCALE <= THR), 1)) { mn = m_reg; alpha = 1.f; }
    else { mn = fmaxf(m_reg, pmax); alpha = __builtin_amdgcn_exp2f((m_reg - mn) * C2); m_reg = mn; }
    const float mnL = -mn * C2;
    for (int r = 0; r < 16; ++r) p0[r] = fmaf(p0[r], C2, mnL); for (int r = 0; r < 16; ++r) p1[r] = fmaf(p1[r], C2, mnL);
    for (int r = 0; r < 16; ++r) p0[r] = __builtin_amdgcn_exp2f(p0[r]);
}
__device__ __forceinline__ void finishSM(f32x16& p0, f32x16& p1, float alpha, float& l_reg, bf16x8& pa0, bf16x8& pa1, bf16x8& pa2, bf16x8& pa3) {
    for (int r = 0; r < 16; ++r) p1[r] = __builtin_amdgcn_exp2f(p1[r]);
    float ps = 0; for (int r = 0; r < 16; ++r) ps += p0[r]; for (int r = 0; r < 16; ++r) ps += p1[r];
    { auto rr = __builtin_amdgcn_permlane32_swap(__float_as_uint(ps), __float_as_uint(ps), false, false);
      ps = __uint_as_float(rr[0]) + __uint_as_float(rr[1]); }
    l_reg = l_reg * alpha + ps;
#define PK4(P, B_, OUT) do { unsigned a0 = cvtpk(P[B_+0], P[B_+1]), a1 = cvtpk(P[B_+2], P[B_+3]);                          \
        unsigned b0 = cvtpk(P[B_+4], P[B_+5]), b1 = cvtpk(P[B_+6], P[B_+7]);                                             \
        auto r0 = __builtin_amdgcn_permlane32_swap(a0, b0, false, false); auto r1 = __builtin_amdgcn_permlane32_swap(a1, b1, false, false); \
        u32x4 w = {r0[0], r1[0], r0[1], r1[1]}; OUT = *reinterpret_cast<bf16x8*>(&w); } while (0)
    PK4(p0, 0, pa0); PK4(p0, 8, pa1); PK4(p1, 0, pa2); PK4(p1, 8, pa3);
#undef PK4
}
template <int KB>
__device__ __forceinline__ void qkt(f32x16& p0, f32x16& p1, const char* K_lds, int r32, int hi, const bf16x8* qr, const float* bp) {
    {
        const f32x4 a0 = *(const f32x4*)(bp), a1 = *(const f32x4*)(bp + 8), a2 = *(const f32x4*)(bp + 16), a3 = *(const f32x4*)(bp + 24);
        const f32x4 c0 = *(const f32x4*)(bp + 32), c1 = *(const f32x4*)(bp + 40), c2 = *(const f32x4*)(bp + 48), c3 = *(const f32x4*)(bp + 56);
#pragma unroll
        for (int i = 0; i < 4; ++i) { p0[i] = a0[i]; p0[4 + i] = a1[i]; p0[8 + i] = a2[i]; p0[12 + i] = a3[i]; p1[i] = c0[i]; p1[4 + i] = c1[i]; p1[8 + i] = c2[i]; p1[12 + i] = c3[i]; }
    }
    const char* kb[4];
#pragma unroll
    for (int dd = 0; dd < 4; ++dd) kb[dd] = K_lds + KB * SHM_K + KSWZ(r32, (dd * 16 + hi * 8) * 2);
#pragma unroll
    for (int d0 = 0; d0 < 8; ++d0) { const char* a = kb[d0 & 3] + (d0 >> 2) * 128;
        bf16x8 b0 = *reinterpret_cast<const bf16x8*>(a);
        bf16x8 b1 = *reinterpret_cast<const bf16x8*>(a + 32 * 256);
        p0 = __builtin_amdgcn_mfma_f32_32x32x16_bf16(b0, qr[d0], p0, 0, 0, 0);
        p1 = __builtin_amdgcn_mfma_f32_32x32x16_bf16(b1, qr[d0], p1, 0, 0, 0); }
}
template <int VB>
__device__ __forceinline__ void pv_tile(f32x16* o, int vb0, bf16x8 pa0, bf16x8 pa1, bf16x8 pa2, bf16x8 pa3) {
#define TRRD(dst, off) asm volatile("ds_read_b64_tr_b16 %0, %1 offset:%2" : "=&v"(dst) : "v"(vb0), "i"(off) : "memory")
#define PV_D0(d0) do { s16x4 l0, l1, l2, l3, h0, h1, h2, h3; constexpr int b_ = VB * SHM_V + v_rd_off(d0, 0, 0);   \
        TRRD(l0, b_); TRRD(h0, b_ + 2048); TRRD(l1, b_ + 4096); TRRD(h1, b_ + 6144); TRRD(l2, b_ + 8192); TRRD(h2, b_ + 10240); TRRD(l3, b_ + 12288); TRRD(h3, b_ + 14336); \
        asm volatile("s_waitcnt lgkmcnt(0)" ::: "memory"); SBAR();   \
        o[d0] = __builtin_amdgcn_mfma_f32_32x32x16_bf16(pa0, (bf16x8){l0[0], l0[1], l0[2], l0[3], h0[0], h0[1], h0[2], h0[3]}, o[d0], 0, 0, 0);   \
        o[d0] = __builtin_amdgcn_mfma_f32_32x32x16_bf16(pa1, (bf16x8){l1[0], l1[1], l1[2], l1[3], h1[0], h1[1], h1[2], h1[3]}, o[d0], 0, 0, 0);   \
        o[d0] = __builtin_amdgcn_mfma_f32_32x32x16_bf16(pa2, (bf16x8){l2[0], l2[1], l2[2], l2[3], h2[0], h2[1], h2[2], h2[3]}, o[d0], 0, 0, 0);   \
        o[d0] = __builtin_amdgcn_mfma_f32_32x32x16_bf16(pa3, (bf16x8){l3[0], l3[1], l3[2], l3[3], h3[0], h3[1], h3[2], h3[3]}, o[d0], 0, 0, 0); } while (0)
    PV_D0(0); PV_D0(1); PV_D0(2); PV_D0(3);
#undef PV_D0
#undef TRRD
}

struct BlockRef { const bf16* Q; const bf16* K; const bf16* V; bf16* O; int P0; int jlo; };
struct Seam { bf16x8 qr[8]; bf16x8 st_v0, st_v1, st_k0, st_k1; };
#define ROW(p, k0, rr) ((p) + (size_t)((k0) + (rr)) * D + sc)
#define VMW() asm volatile("s_waitcnt vmcnt(0)" ::: "memory")
#define VMWN(n) asm volatile("s_waitcnt vmcnt(%0)" :: "i"(n) : "memory")
#define SLOAD_H(Kp, Vp, k0) do { S.st_v0 = load8(ROW(Vp, k0, sr)); S.st_v1 = load8(ROW(Vp, k0, 32 + sr));              \
                         S.st_k0 = load8(ROW(Kp, k0, sr)); S.st_k1 = load8(ROW(Kp, k0, 32 + sr)); } while (0)
#define SWRITE_HK(bf) do { *(bf16x8*)(K_lds + (bf) * SHM_K + kws) = S.st_k0; *(bf16x8*)(K_lds + (bf) * SHM_K + kws + 32 * 256) = S.st_k1; } while (0)
#define SWRITE_HV(bf) do { *(bf16x8*)(V_lds + (bf) * SHM_V + vst0) = S.st_v0; *(bf16x8*)(V_lds + (bf) * SHM_V + vst1) = S.st_v1; } while (0)
#define SWRITE_H(bf) do { SWRITE_HV(bf); SWRITE_HK(bf); } while (0)
__device__ __forceinline__ void attn_prime(const BlockRef& cur, char* lds, Seam& S) {
    const int tid = threadIdx.x, wid = __builtin_amdgcn_readfirstlane(tid >> 6), lane = tid & 63, r32 = lane & 31, hi = lane >> 5;
    const int sr = tid >> 4, sc = (tid & 15) * 8, kws = KSWZ(sr, sc * 2); char* K_lds = lds + 2 * SHM_V;
    const int kb0 = cur.jlo * KVBLK;
#pragma unroll
    for (int d0 = 0; d0 < 8; ++d0) S.qr[d0] = load8(cur.Q + (size_t)(wid * QBLK + r32) * D + d0 * 16 + hi * 8);
    SLOAD_H(cur.K, cur.V, kb0); VMW(); SWRITE_HK(0);
    __syncthreads();
}
__device__ __forceinline__ void attn_block(const BlockRef& cur, const BlockRef& nxt, char* lds, Seam& S) {
    const int tid = threadIdx.x, wid = __builtin_amdgcn_readfirstlane(tid >> 6), lane = tid & 63, r32 = lane & 31, hi = lane >> 5;
    const int j_lo = cur.jlo;
    const int j_hi = (cur.P0 + QB - 1) / KVBLK + 1;
    const int NT = j_hi - j_lo;
    const int kbn = nxt.jlo * KVBLK;
    const int qlo = cur.P0 + wid * QBLK, qm = qlo + r32 - 4 * hi;
    char* V_lds = lds; char* K_lds = lds + 2 * SHM_V;
    float* ws = (float*)(lds + WS_OFF) + wid * 64; float* li_l = ws, * al_l = ws + 32;
    const float* bias_l = (const float*)(lds + BIAS_OFF) + 4 * hi;
    float m_reg = -1e30f, l_reg = 0; f32x16 o[4] = {};
    const int sr = tid >> 4, sc = (tid & 15) * 8, vst0 = v_st(sr, sc), vst1 = v_st(32 + sr, sc), kws = KSWZ(sr, sc * 2);
    const int vb0 = (int)(uintptr_t)V_lds + v_rd_base(lane);
    const bf16* Kh = cur.K; const bf16* Vh = cur.V;
#define RESC(a) do { if (__any((a) < 1.f)) { if (hi == 0) al_l[r32] = (a); asm volatile("s_waitcnt lgkmcnt(0)" ::: "memory");              \
                     for (int d_ = 0; d_ < 4; ++d_) for (int r = 0; r < 16; ++r) o[d_][r] *= al_l[crow(r, hi)]; } } while (0)
#define KBASE(t) ((j_lo + (t)) * KVBLK)
#define MASKT(P0_, P1_, t) do { const int kb_ = KBASE(t); if (kb_ + KVBLK - 1 > qlo) mask_tile(P0_, P1_, qm - kb_, WBIG); } while (0)
    constexpr int NQL = 8;
#define SEAM_K0() do { VMWN(NQL); SWRITE_HK(0); SBAR(); } while (0)
    f32x16 pA0, pA1, pB0, pB1; float mnA, mnB, alA, alB; bf16x8 pa0, pa1, pa2, pa3;
    SWRITE_HV(0); SBAR();
    if (NT > 1) { SLOAD_H(Kh, Vh, KBASE(1)); }
    SBAR(); qkt<0>(pA0, pA1, K_lds, r32, hi, S.qr, bias_l + KBASE(0));
    MASKT(pA0, pA1, 0); partialSM(pA0, pA1, m_reg, mnA, alA);
    if (NT > 1) { VMW(); SWRITE_H(1); }
    __syncthreads();
#define HALF_STEP(PX0, PX1, mnX, alX, PY0, PY1, alY, t, KB, VB, SB) do {                                                      \
        SBAR(); qkt<KB>(PX0, PX1, K_lds, r32, hi, S.qr, bias_l + KBASE(t));                                                   \
        finishSM(PY0, PY1, alY, l_reg, pa0, pa1, pa2, pa3); SBAR();                                                           \
        if ((t) + 1 < NT) { SLOAD_H(Kh, Vh, KBASE((t) + 1)); SBAR(); }                                                        \
        pv_tile<VB>(o, vb0, pa0, pa1, pa2, pa3); MASKT(PX0, PX1, (t)); partialSM(PX0, PX1, m_reg, mnX, alX);                  \
        __syncthreads();                                                                                                      \
        if ((t) + 1 < NT) { VMW(); SWRITE_H(SB); }                                                                            \
        RESC(alX); __syncthreads(); } while (0)
    for (int t = 1; t + 1 < NT; t += 2) {
        HALF_STEP(pB0, pB1, mnB, alB, pA0, pA1, alA, t, 1, 0, 0);
        HALF_STEP(pA0, pA1, mnA, alA, pB0, pB1, alB, t + 1, 0, 1, 1);
    }
    const bool even = (NT & 1) == 0;
    if (even) { SBAR(); qkt<1>(pB0, pB1, K_lds, r32, hi, S.qr, bias_l + KBASE(NT - 1)); SBAR(); }
    SLOAD_H(nxt.K, nxt.V, kbn); SBAR();
    int tz = threadIdx.x; asm volatile("" : "+v"(tz));
    const int r32b = tz & 31, hib = (tz >> 5) & 1;
    { const bf16* qn = nxt.Q + (unsigned)((wid * QBLK + r32b) * D + hib * 8);
#pragma unroll
    for (int d0 = 0; d0 < 8; ++d0) S.qr[d0] = load8(qn + d0 * 16); }
    SBAR();
    finishSM(pA0, pA1, alA, l_reg, pa0, pa1, pa2, pa3); SBAR();
    pv_tile<0>(o, vb0, pa0, pa1, pa2, pa3);
    if (even) { MASKT(pB0, pB1, NT - 1); partialSM(pB0, pB1, m_reg, mnB, alB); __syncthreads(); RESC(alB);
        finishSM(pB0, pB1, alB, l_reg, pa0, pa1, pa2, pa3); SBAR(); pv_tile<1>(o, vb0, pa0, pa1, pa2, pa3); }
    SBAR(); SEAM_K0();
    if (hi == 0) li_l[r32] = l_reg; asm volatile("s_waitcnt lgkmcnt(0)" ::: "memory");
    float rli[16];
#pragma unroll
    for (int r = 0; r < 16; ++r) rli[r] = __builtin_amdgcn_rcpf(li_l[crow(r, hi)]);
    bf16* Ow = cur.O + (size_t)(wid * QBLK) * OP + (unsigned)(4 * hib * OP + r32b);
#pragma unroll
    for (int r = 0; r < 16; ++r) { const int orow0 = (r & 3) + 8 * (r >> 2);
#pragma unroll
        for (int d0 = 0; d0 < 4; ++d0) { const float v = o[d0][r] * rli[r];
            const float vn = __shfl_xor(v, 1);
            if ((r32b & 1) == 0) *(unsigned*)(Ow + orow0 * OP + d0 * 32) = cvtpk(v, vn); } }
    __syncthreads();
#undef RESC
#undef KBASE
#undef MASKT
#undef SEAM_K0
#undef HALF_STEP
}
#undef ROW
#undef VMW
#undef VMWN
#undef SLOAD_H
#undef SWRITE_HK
#undef SWRITE_HV
#undef SWRITE_H
#undef KSWZ
#undef SBAR
}

constexpr int NWAVES = 8;
constexpr int N_LAUNCHES = MK_N_LAUNCHES;
constexpr int N_PHASES = 13;
constexpr int DM = 4096, SEQ = 8192, NMETA = 16, DFF = 11008, NGU = 2 * DFF, INCOLS = 12304, NQKV = 12288, NIN = 12544, HD = 128;
constexpr int PADF = 240, XR0 = 256, MP = 8448;
constexpr int NCHUNK = 96;
constexpr float RMS_EPS = 1e-6f, SUBLN_EPS = 1e-5f, LAMBDA_INIT = 0.2f;
constexpr float INV_SCALE = 11.313708498984761f;

constexpr size_t MiB = 1u << 20;
constexpr size_t WS_CTL = 0, CTL_ZERO_BYTES = 1 * MiB;
constexpr size_t SZ_WGU = (size_t)NGU * DM * 2, SZ_WD = (size_t)DM * DFF * 2, SZ_WIN = (size_t)NIN * DM * 2, SZ_WOUT = (size_t)DM * DM * 2;
constexpr size_t WS_W1GU = 1 * MiB, WS_W1D = WS_W1GU + SZ_WGU, WS_WIN = WS_W1D + SZ_WD, WS_WOUT = WS_WIN + SZ_WIN, WS_W2GU = WS_WOUT + SZ_WOUT, WS_W2D = WS_W2GU + SZ_WGU;
constexpr size_t WS_H = WS_W2D + SZ_WD;
constexpr size_t WS_XN = WS_H + (size_t)MP * DM * 4;
constexpr size_t WS_BIG = WS_XN + (size_t)MP * DM * 2;
constexpr size_t SZ_BIG = (size_t)NCHUNK * MP * HD * 2;
constexpr size_t WS_O = WS_BIG + SZ_BIG;
constexpr size_t WS_O1 = WS_O + (size_t)MP * DM * 2;
constexpr size_t WS_LOGIT = WS_O1 + (size_t)MP * DM * 2;
constexpr size_t WS_BIAS = WS_LOGIT + (size_t)MP * 16 * 4;
constexpr size_t WS_END = WS_BIAS + (size_t)24 * MP * 4;
static_assert((size_t)MP * DFF * 2 <= SZ_BIG, "FFN hidden fits the shared region");
static_assert(WS_W1GU % 256 == 0 && WS_W1D % 256 == 0 && WS_WIN % 256 == 0 && WS_H % 256 == 0 && WS_XN % 256 == 0 && WS_BIG % 256 == 0 && WS_O % 256 == 0 && WS_LOGIT % 256 == 0 && WS_BIAS % 256 == 0, "alignment");
constexpr int CW_BAR = 4096;
constexpr int CW_QUEUE = 8192;
constexpr int CW_T1Q = 9216, CW_CONVQ = 9280, CW_CONVQ2 = 9344;
constexpr int CW_NORM = 12288;

constexpr int RING_OFF = 0, RING_BYTES = 135168;
constexpr int LDSCTL_OFF = RING_BYTES, MISC_OFF = LDSCTL_OFF + 320;
constexpr int LDS_BYTES = 147456;
static_assert(MISC_OFF + 128 <= LDS_BYTES && att::ATT_LDS_BYTES <= RING_BYTES, "LDS map");

#define GAS __attribute__((address_space(1)))
#define LAS __attribute__((address_space(3)))
typedef unsigned short bf16;
typedef unsigned v4u __attribute__((ext_vector_type(4)));
typedef unsigned v2u __attribute__((ext_vector_type(2)));
typedef float f32x4 __attribute__((ext_vector_type(4)));
typedef GAS unsigned gu32;
#define RLX_AGENT __ATOMIC_RELAXED, __HIP_MEMORY_SCOPE_AGENT
#define LDS_WAIT() asm volatile("s_waitcnt lgkmcnt(0)" ::: "memory")
#define VM_WAIT() asm volatile("s_waitcnt vmcnt(0)" ::: "memory")
__device__ __forceinline__ unsigned f2bf(float f) { unsigned u = __builtin_bit_cast(unsigned, f); return (u + 0x7fffu + ((u >> 16) & 1u)) >> 16; }
__device__ __forceinline__ unsigned pk2(float lo, float hi) { return f2bf(lo) | (f2bf(hi) << 16); }
__device__ __forceinline__ float bf_lo(unsigned w) { return __builtin_bit_cast(float, w << 16); }
__device__ __forceinline__ float bf_hi(unsigned w) { return __builtin_bit_cast(float, w & 0xffff0000u); }
#define XB_TMO      128
#define XB_XCNT(j)  (256  + 64 * (j))
#define XB_XSUB(j)  (1280 + 64 * (j))
#define XB_XGEN(j)  (2304 + 64 * (j))
#define XB_TOP      3328
#define XB_TOPGEN   3392
#define XCD_BAR_WORDS 3456
#define XB_SPIN_CAP (1u << 18)

__device__ __forceinline__ unsigned xb_ld(unsigned* p)              { return __hip_atomic_load(p, __ATOMIC_RELAXED, __HIP_MEMORY_SCOPE_AGENT); }
__device__ __forceinline__ unsigned xb_add(unsigned* p, unsigned v) { return __hip_atomic_fetch_add(p, v, __ATOMIC_RELAXED, __HIP_MEMORY_SCOPE_AGENT); }
__device__ __forceinline__ unsigned xb_xcc_id() { return (unsigned)__builtin_amdgcn_s_getreg((3 << 11) | 20) & 0xFu; }
#define XB_SPIN(cond, bar) do { unsigned _sp = 0; while (cond) { __builtin_amdgcn_s_sleep(1); \
    if ((++_sp & 255u) == 0u) { if (xb_ld(&(bar)[XB_TMO])) break; if (_sp > XB_SPIN_CAP) { atomicAdd(&(bar)[XB_TMO], 1u); break; } } } } while (0)

struct XcdBarrier {
    unsigned* bar; unsigned x;
    volatile LAS unsigned* st;
};

__device__ __forceinline__ XcdBarrier xcd_barrier_post(unsigned* bar, volatile LAS unsigned* st) {
    XcdBarrier b; b.bar = bar; b.x = xb_xcc_id(); b.st = st;
    if (threadIdx.x == 0) (void)xb_add(&bar[XB_XCNT(b.x)], 1u);
    return b;
}
__device__ __forceinline__ void xcd_barrier_complete(unsigned* bar, unsigned x, unsigned& nloc, unsigned& nx) {
    const unsigned G = gridDim.x * gridDim.y * gridDim.z;
    unsigned sum, cnt, mine, sp = 0u;
    for (;;) {
        sum = 0u; cnt = 0u; mine = 0u;
#pragma unroll
        for (unsigned j = 0; j < 16; ++j) { const unsigned c = xb_ld(&bar[XB_XCNT(j)]); sum += c; cnt += (c > 0u) ? 1u : 0u; mine = (j == x) ? c : mine; }
        if (sum == G) break;
        __builtin_amdgcn_s_sleep(1);
        if ((++sp & 255u) == 0u) { if (xb_ld(&bar[XB_TMO])) break; if (sp > XB_SPIN_CAP) { atomicAdd(&bar[XB_TMO], 1u); break; } }
    }
    nloc = mine > 0u ? mine : 1u; nx = cnt > 0u ? cnt : 1u;
}

__device__ __forceinline__ void xcd_barrier(const XcdBarrier& b) {
    asm volatile("s_waitcnt vmcnt(0)" ::: "memory");
    __syncthreads();
    if (threadIdx.x == 0) {
        unsigned* bar = b.bar;
        __builtin_amdgcn_s_waitcnt(0);
        unsigned nloc = b.st[0], nx = b.st[1];
        if (nloc == 0u) { xcd_barrier_complete(bar, b.x, nloc, nx); b.st[0] = nloc; b.st[1] = nx; }
        const unsigned old = xb_add(&bar[XB_XSUB(b.x)], 1u);
        const unsigned gen = old / nloc;
        if (old + 1u == (gen + 1u) * nloc) {
            __builtin_amdgcn_fence(__ATOMIC_RELEASE, "agent");
            asm volatile("s_waitcnt vmcnt(0)" ::: "memory");
            const unsigned og = xb_add(&bar[XB_TOP], 1u);
            const unsigned tg = og / nx;
            if (og + 1u == (tg + 1u) * nx) xb_add(&bar[XB_TOPGEN], 1u);
            else XB_SPIN(xb_ld(&bar[XB_TOPGEN]) == tg, bar);
            __builtin_amdgcn_fence(__ATOMIC_ACQUIRE, "agent");
            xb_add(&bar[XB_XGEN(b.x)], 1u);
            asm volatile("s_waitcnt vmcnt(0)" ::: "memory");
        } else {
            XB_SPIN(xb_ld(&bar[XB_XGEN(b.x)]) == gen, bar);
            __builtin_amdgcn_fence(__ATOMIC_ACQUIRE, "agent");
            asm volatile("s_waitcnt vmcnt(0)" ::: "memory");
        }
    }
    __syncthreads();
}


struct Frame {
    LAS unsigned char* lds;
    volatile LAS unsigned* MISC;
    gu32* ctl;
    int tid, lane, wave;
    int vcu, G;
};
__device__ __forceinline__ float wave_sum(float v) {
#pragma unroll
    for (int o = 1; o < 64; o <<= 1) v += __shfl_xor(v, o);
    return v;
}
struct TItem { const float* src; bf16* dst; const float* gain; int ldw, K, ncol, pad; };
__device__ __forceinline__ void t_load(f32x4 (&v)[16], const TItem& t, int lane) {
    const int q = lane & 15, g = lane >> 4; const bool ok = 4 * q < t.ncol;
    const float* p = t.src + (size_t)g * t.ldw + 4 * q;
#pragma unroll
    for (int i = 0; i < 16; ++i) v[i] = ok ? __builtin_nontemporal_load((const GAS f32x4*)(p + (size_t)(4 * i) * t.ldw)) : (f32x4){0.f, 0.f, 0.f, 0.f};
}
__device__ __forceinline__ void t_store(const f32x4 (&v)[16], const TItem& t, LAS float* scr, int lane) {
    const int q = lane & 15, g = lane >> 4;
    LAS float* w = scr + g * 65 + 4 * q;
#pragma unroll
    for (int i = 0; i < 16; ++i) { w[(4 * i) * 65 + 0] = v[i].x; w[(4 * i) * 65 + 1] = v[i].y; w[(4 * i) * 65 + 2] = v[i].z; w[(4 * i) * 65 + 3] = v[i].w; }
    LDS_WAIT(); asm volatile("" ::: "memory");
    const int c = lane & 7, nn = lane >> 3;
    const LAS float* s = scr + (8 * c) * 65 + nn;
    bf16* d = t.dst + (size_t)nn * t.K + 8 * c;
    f32x4 ga = {1.f, 1.f, 1.f, 1.f}, gb = {1.f, 1.f, 1.f, 1.f};
    if (t.gain) { ga = *(const GAS f32x4*)(t.gain + 8 * c); gb = *(const GAS f32x4*)(t.gain + 8 * c + 4); }
#pragma unroll
    for (int j = 0; j < 8; ++j) { v4u o;
        o.x = pg8::cvt_pk_bf16(s[8 * j + 0 * 65] * ga.x, s[8 * j + 1 * 65] * ga.y); o.y = pg8::cvt_pk_bf16(s[8 * j + 2 * 65] * ga.z, s[8 * j + 3 * 65] * ga.w);
        o.z = pg8::cvt_pk_bf16(s[8 * j + 4 * 65] * gb.x, s[8 * j + 5 * 65] * gb.y); o.w = pg8::cvt_pk_bf16(s[8 * j + 6 * 65] * gb.z, s[8 * j + 7 * 65] * gb.w);
        __builtin_nontemporal_store(o, (GAS v4u*)(d + (size_t)(8 * j) * t.K)); }
    LDS_WAIT(); asm volatile("" ::: "memory");
}
__device__ __forceinline__ TItem t_item(const float* W, int ldw, int K, int nblk, int ncols, bf16* WT, int blk, int off, int r, const float* gain) {
    const int kb = r / nblk, nb = r - kb * nblk, n0 = 64 * nb;
    TItem t; t.src = W + (size_t)(64 * kb) * ldw + n0; t.dst = WT + (size_t)((n0 >> 7) * blk + off + (n0 & 127)) * K + 64 * kb; t.ldw = ldw; t.K = K;
    t.ncol = (ncols - n0) < 64 ? (ncols - n0) : 64; t.pad = 0; t.gain = gain ? gain + 64 * kb : nullptr; return t;
}
__device__ __forceinline__ void raw_row_bf16(const float* xrow, bf16* orow, unsigned long long* ss, int lane) {
    const GAS f32x4* xr = (const GAS f32x4*)xrow + lane;
    f32x4 v[16]; float s = 0.f;
#pragma unroll
    for (int j = 0; j < 16; ++j) { v[j] = xr[64 * j]; s += (v[j].x * v[j].x + v[j].y * v[j].y) + (v[j].z * v[j].z + v[j].w * v[j].w); }
    s = wave_sum(s);
    GAS v2u* o8 = (GAS v2u*)orow + lane;
#pragma unroll
    for (int j = 0; j < 16; ++j) { v2u w; w.x = pg8::cvt_pk_bf16(v[j].x, v[j].y); w.y = pg8::cvt_pk_bf16(v[j].z, v[j].w); o8[64 * j] = w; }
    if (lane == 0) *ss = (unsigned long long)(s * 16777216.0f);
}
__device__ __forceinline__ void norm_row_bf16(const float* xrow, const float* gain, bf16* orow, int lane, float eps) {
    const GAS f32x4* xr = (const GAS f32x4*)xrow + lane; const GAS f32x4* gr = (const GAS f32x4*)gain + lane;
    f32x4 v[16]; float s = 0.f;
#pragma unroll
    for (int j = 0; j < 16; ++j) { v[j] = xr[64 * j]; s += (v[j].x * v[j].x + v[j].y * v[j].y) + (v[j].z * v[j].z + v[j].w * v[j].w); }
    const float r = 1.0f / sqrtf(wave_sum(s) * (1.0f / DM) + eps);
    GAS v2u* o8 = (GAS v2u*)orow + lane;
#pragma unroll
    for (int j = 0; j < 16; ++j) { const f32x4 g = gr[64 * j]; v2u w; w.x = pk2(v[j].x * r * g.x, v[j].y * r * g.y); w.y = pk2(v[j].z * r * g.z, v[j].w * r * g.w); o8[64 * j] = w; }
}
__device__ __forceinline__ void norm_row_f32(const float* xrow, const float* gain, float* orow, int lane, float eps) {
    const GAS f32x4* xr = (const GAS f32x4*)xrow + lane; const GAS f32x4* gr = (const GAS f32x4*)gain + lane;
    f32x4 v[16]; float s = 0.f;
#pragma unroll
    for (int j = 0; j < 16; ++j) { v[j] = xr[64 * j]; s += (v[j].x * v[j].x + v[j].y * v[j].y) + (v[j].z * v[j].z + v[j].w * v[j].w); }
    const float r = 1.0f / sqrtf(wave_sum(s) * (1.0f / DM) + eps);
    GAS f32x4* o = (GAS f32x4*)orow + lane;
#pragma unroll
    for (int j = 0; j < 16; ++j) { const f32x4 g = gr[64 * j]; f32x4 w; w.x = v[j].x * r * g.x; w.y = v[j].y * r * g.y; w.z = v[j].z * r * g.z; w.w = v[j].w * r * g.w; o[64 * j] = w; }
}


typedef short bf16x8_t __attribute__((ext_vector_type(8)));
__device__ __forceinline__ f32x4 thin16(const bf16* a, const bf16* b, int nsteps) {
    f32x4 acc = {0.f, 0.f, 0.f, 0.f};
    int s = 0;
    for (; s + 16 <= nsteps; s += 16) {
        bf16x8_t av[16], bv[16];
#pragma unroll
        for (int u = 0; u < 16; ++u) { av[u] = *(const GAS bf16x8_t*)(a + (s + u) * 32); bv[u] = *(const GAS bf16x8_t*)(b + (s + u) * 32); }
#pragma unroll
        for (int u = 0; u < 16; ++u) acc = __builtin_amdgcn_mfma_f32_16x16x32_bf16(av[u], bv[u], acc, 0, 0, 0);
    }
    if (s < nsteps) {
        bf16x8_t av[15], bv[15];
#pragma unroll
        for (int u = 0; u < 15; ++u) if (s + u < nsteps) { av[u] = *(const GAS bf16x8_t*)(a + (s + u) * 32); bv[u] = *(const GAS bf16x8_t*)(b + (s + u) * 32); }
#pragma unroll
        for (int u = 0; u < 15; ++u) if (s + u < nsteps) acc = __builtin_amdgcn_mfma_f32_16x16x32_bf16(av[u], bv[u], acc, 0, 0, 0);
    }
    return acc;
}
__device__ __forceinline__ void thin16x2(const bf16* a, const bf16* b0, const bf16* b1, int nsteps, f32x4& acc0, f32x4& acc1) {
    acc0 = (f32x4){0.f, 0.f, 0.f, 0.f}; acc1 = (f32x4){0.f, 0.f, 0.f, 0.f};
    for (int s = 0; s + 8 <= nsteps; s += 8) {
        bf16x8_t av[8], bv[8], cv[8];
#pragma unroll
        for (int u = 0; u < 8; ++u) { av[u] = *(const GAS bf16x8_t*)(a + (s + u) * 32); bv[u] = *(const GAS bf16x8_t*)(b0 + (s + u) * 32); cv[u] = *(const GAS bf16x8_t*)(b1 + (s + u) * 32); }
#pragma unroll
        for (int u = 0; u < 8; ++u) { acc0 = __builtin_amdgcn_mfma_f32_16x16x32_bf16(av[u], bv[u], acc0, 0, 0, 0); acc1 = __builtin_amdgcn_mfma_f32_16x16x32_bf16(av[u], cv[u], acc1, 0, 0, 0); }
    }
}
__device__ __forceinline__ float thin_reduce(LAS float* red, f32x4 acc, int tid, int lane, int wave) {
    *(LAS f32x4*)(red + wave * 256 + lane * 4) = acc;
    __syncthreads();
    float s = 0.f;
    if (tid < 256) {
#pragma unroll
        for (int w = 0; w < 8; ++w) s += red[w * 256 + tid];
    }
    __syncthreads();
    return s;
}
__device__ __forceinline__ int hidden_tid() { int t = threadIdx.x; asm volatile("" : "+v"(t)); return t; }
struct Args { const float* in[20]; float* out; unsigned char* ws; int ph_lo, ph_hi; };

__global__ void __launch_bounds__(NWAVES * 64, 2) hymba_fwd(Args args) {
    extern __shared__ __attribute__((aligned(16))) unsigned char lds[];
    Frame F;
    F.lds = (LAS unsigned char*)lds;
    F.MISC = (volatile LAS unsigned*)(F.lds + MISC_OFF);
    F.tid = threadIdx.x; F.lane = F.tid & 63; F.wave = __builtin_amdgcn_readfirstlane(F.tid >> 6);
    F.G = gridDim.x; { const int bx = blockIdx.x; F.vcu = (F.G % 8 == 0) ? (bx % 8) * (F.G / 8) + bx / 8 : bx; }
    unsigned char* ws = args.ws;
    F.ctl = (gu32*)(ws + WS_CTL);
    const float* x = args.in[0]; const float* meta = args.in[1];
    bf16* W1GU = (bf16*)(ws + WS_W1GU); bf16* W1D = (bf16*)(ws + WS_W1D); bf16* WIN = (bf16*)(ws + WS_WIN); bf16* WOUT = (bf16*)(ws + WS_WOUT);
    bf16* W2GU = (bf16*)(ws + WS_W2GU); bf16* W2D = (bf16*)(ws + WS_W2D);
    float* H = (float*)(ws + WS_H); bf16* XN = (bf16*)(ws + WS_XN); bf16* ACT = (bf16*)(ws + WS_BIG); bf16* PROJ = (bf16*)(ws + WS_BIG);
    bf16* OB = (bf16*)(ws + WS_O); bf16* O1B = (bf16*)(ws + WS_O1); float* LOGIT = (float*)(ws + WS_LOGIT); float* BIAS = (float*)(ws + WS_BIAS);
    unsigned long long* SS0 = (unsigned long long*)(ws + WS_CTL + 256 * 1024); unsigned long long* SS1 = (unsigned long long*)(ws + WS_CTL + 384 * 1024); unsigned long long* SS2 = (unsigned long long*)(ws + WS_CTL + 512 * 1024);
    for (int u = F.tid; u < (LDS_BYTES - LDSCTL_OFF) / 4; u += NWAVES * 64) ((LAS unsigned*)(F.lds + LDSCTL_OFF))[u] = 0u;
    __syncthreads();
    XcdBarrier bar; bar.bar = (unsigned*)(F.ctl + CW_BAR); bar.x = 0; bar.st = nullptr;
    if (N_LAUNCHES == 1) bar = xcd_barrier_post((unsigned*)(F.ctl + CW_BAR), F.MISC + 8);
#define GRID_BAR() do { if (N_LAUNCHES == 1) xcd_barrier(bar); } while (0)
    const int lo = args.ph_lo, hi = args.ph_hi;
#define IN(k) (lo <= (k) && (k) < hi)
#define BOTH(k) (IN(k) && IN((k) + 1))
    const int gw = F.vcu * NWAVES + F.wave, NGW = F.G * NWAVES;

    constexpr int I_GU = (DM / 64) * (DFF / 64), I_D = (DFF / 64) * (DM / 64), I_IN = (DM / 64) * 193, I_OUT = (DM / 64) * (DM / 64);
    constexpr int NITEMS = 4 * I_GU + 2 * I_D + I_IN + I_OUT, N0 = 2 * I_GU;
#define T_DECODE(T_, it_) do { int r_ = (it_);                                                                                     \
            if (r_ < I_GU) { T_ = t_item(args.in[3], DFF, DM, DFF / 64, DFF, W1GU, 256, 0, r_, args.in[2]); break; } r_ -= I_GU;                 \
            if (r_ < I_GU) { T_ = t_item(args.in[4], DFF, DM, DFF / 64, DFF, W1GU, 256, 128, r_, args.in[2]); break; } r_ -= I_GU;               \
            if (r_ < I_D) { T_ = t_item(args.in[5], DM, DFF, DM / 64, DM, W1D, 128, 0, r_, nullptr); break; } r_ -= I_D;                      \
            if (r_ < I_IN) { T_ = t_item(args.in[7], INCOLS, DM, 193, INCOLS, WIN, 128, 0, r_, args.in[6]); break; } r_ -= I_IN;                 \
            if (r_ < I_OUT) { T_ = t_item(args.in[14], DM, DM, DM / 64, DM, WOUT, 128, 0, r_, nullptr); break; } r_ -= I_OUT;                 \
            if (r_ < I_GU) { T_ = t_item(args.in[16], DFF, DM, DFF / 64, DFF, W2GU, 256, 0, r_, args.in[15]); break; } r_ -= I_GU;                \
            if (r_ < I_GU) { T_ = t_item(args.in[17], DFF, DM, DFF / 64, DFF, W2GU, 256, 128, r_, args.in[15]); break; } r_ -= I_GU;              \
            T_ = t_item(args.in[18], DM, DFF, DM / 64, DM, W2D, 128, 0, r_, nullptr); } while (0)
#define Q_POP(dst_, QW_) do { int v_ = 0; if (lane == 0) v_ = (int)__hip_atomic_fetch_add((unsigned*)(F.ctl + (QW_)), 8u, RLX_AGENT); dst_ = __builtin_amdgcn_readfirstlane(v_); } while (0)
#define Q_NEXT(dst_, QW_) do { if (q_it >= q_end) { if (q_next < NQ) { q_it = q_next; q_end = (q_next + CHK) < NQ ? (q_next + CHK) : NQ; Q_POP(q_next, QW_); } } \
                          if (q_it < q_end) { dst_ = q_it; ++q_it; } else dst_ = -1; } while (0)
#define CONV_STREAM(QW_, FIRST_, COUNT_) do { \
        { \
            LAS float* scr = (LAS float*)(F.lds + RING_OFF + F.wave * 16640); \
            const int NQ = (COUNT_); constexpr int CHK = 8; \
            int q_it = 0, q_end = 0, q_next = 0; \
            Q_POP(q_next, QW_); \
            f32x4 va[16], vb[16], vc[16]; TItem ta, tb, tc; int i0, i1, i2; \
            Q_NEXT(i0, QW_); if (i0 >= 0) { T_DECODE(ta, (FIRST_) + i0); t_load(va, ta, lane); } \
            Q_NEXT(i1, QW_); if (i1 >= 0) { T_DECODE(tb, (FIRST_) + i1); t_load(vb, tb, lane); } \
            for (;;) { \
                if (i0 < 0) break; \
                Q_NEXT(i2, QW_); if (i2 >= 0) { T_DECODE(tc, (FIRST_) + i2); t_load(vc, tc, lane); } \
                t_store(va, ta, scr, lane); \
                if (i1 < 0) break; \
                Q_NEXT(i0, QW_); if (i0 >= 0) { T_DECODE(ta, (FIRST_) + i0); t_load(va, ta, lane); } \
                t_store(vb, tb, scr, lane); \
                if (i2 < 0) break; \
                Q_NEXT(i1, QW_); if (i1 >= 0) { T_DECODE(tb, (FIRST_) + i1); t_load(vb, tb, lane); } \
                t_store(vc, tc, scr, lane); \
            } \
        } \
    } while (0)
    if (IN(0)) {
        const int tid = hidden_tid(), lane = tid & 63; (void)tid; (void)lane;
        LAS float* scr = (LAS float*)(F.lds + RING_OFF + F.wave * 16640);
        {
            f32x4 va[16], vb[16]; TItem ta, tb;
            int it = gw;
            if (it < N0) {
                T_DECODE(ta, it); t_load(va, ta, lane);
                for (;;) {
                    const int itn = it + NGW;
                    if (itn < N0) { T_DECODE(tb, itn); t_load(vb, tb, lane); }
                    t_store(va, ta, scr, lane);
                    if (itn >= N0) break;
                    const int it2 = itn + NGW;
                    if (it2 < N0) { T_DECODE(ta, it2); t_load(va, ta, lane); }
                    t_store(vb, tb, scr, lane);
                    if (it2 >= N0) break;
                    it = it2;
                }
            }
        }
        { GAS v4u* z = (GAS v4u*)(WIN + (size_t)12352 * DM); const size_t n16 = (size_t)(NIN - 12352) * DM * 2 / 16;
          for (size_t i = (size_t)blockIdx.x * 512 + tid; i < n16; i += (size_t)F.G * 512) z[i] = (v4u){0u, 0u, 0u, 0u}; }
        for (int m = PADF + gw; m < MP; m += NGW)
            raw_row_bf16(m < XR0 ? meta + (size_t)(m - PADF) * DM : x + (size_t)(m - XR0) * DM, XN + (size_t)m * DM, SS0 + m, lane);
        if (BOTH(0)) GRID_BAR();
    }
    if (IN(1)) {
        constexpr int GG = 232;
        const int tid = hidden_tid(), lane = tid & 63;
        volatile LAS int* MQ = (volatile LAS int*)(F.lds + MISC_OFF) + 16;
        if ((int)blockIdx.x < GG) {
            pg8::Gemm g{XN + (size_t)XR0 * DM, W1GU, SEQ, NGU, DM}; pg8::StaticOrder S; S.init(SEQ, NGU, GG, (int)blockIdx.x);
            pg8::EpiSwiGLU E{ACT, DFF, XR0, SS0};
            pg8::gemm_phase<pg8::EpiSwiGLU, pg8::StaticOrder, true, true>(F.lds + RING_OFF, g, S, E);
        }
        {
            LAS float* red = (LAS float*)(F.lds + RING_OFF);
            const bf16* a = XN + (size_t)(PADF + (lane & 15)) * DM + 512 * F.wave + 8 * (lane >> 4);
            for (;;) {
                if (tid == 0) MQ[4] = (int)__hip_atomic_fetch_add((unsigned*)(F.ctl + CW_T1Q), 4u, RLX_AGENT);
                __syncthreads();
                const int cb0 = MQ[4];
                if (cb0 >= DFF / 16) break;
                f32x4 ag[4], au[4];
#pragma unroll
                for (int i = 0; i < 4; ++i) { const int c0 = 16 * (cb0 + i); const bf16* b0 = W1GU + (size_t)((c0 >> 7) * 256 + (c0 & 127) + (lane & 15)) * DM + 512 * F.wave + 8 * (lane >> 4);
                    thin16x2(a, b0, b0 + (size_t)128 * DM, 16, ag[i], au[i]); }
#pragma unroll
                for (int i = 0; i < 4; ++i) { *(LAS f32x4*)(red + ((2 * i) * 8 + F.wave) * 256 + lane * 4) = ag[i]; *(LAS f32x4*)(red + ((2 * i + 1) * 8 + F.wave) * 256 + lane * 4) = au[i]; }
                __syncthreads();
                if (tid < 256) { const int l = tid >> 2, tok = 4 * (l >> 4) + (tid & 3), col = l & 15; const float rs = pg8::rstd_of(SS0, PADF + tok, RMS_EPS);
#pragma unroll
                    for (int i = 0; i < 4; ++i) { float gs = 0.f, us = 0.f;
#pragma unroll
                        for (int w = 0; w < 8; ++w) { gs += red[((2 * i) * 8 + w) * 256 + tid]; us += red[((2 * i + 1) * 8 + w) * 256 + tid]; }
                        ACT[(size_t)(PADF + tok) * DFF + 16 * (cb0 + i) + col] = (bf16)f2bf(pg8::silu_mul(gs * rs, us * rs)); } }
                __syncthreads();
            }
            __syncthreads();
        }
        CONV_STREAM(CW_CONVQ, N0, NITEMS - N0 - I_D);
        if (BOTH(1)) GRID_BAR();
    }
    if (IN(2)) {
        pg8::Gemm g{ACT + (size_t)XR0 * DFF, W1D, SEQ, DM, DFF}; pg8::StaticOrder S; S.init(SEQ, DM, F.G, (int)blockIdx.x);
        pg8::EpiResid<true> E{x, XR0, H, DM, 0.5f, XR0, XN, SS1};
        pg8::gemm_phase<pg8::EpiResid<true>, pg8::StaticOrder, true, true>(F.lds + RING_OFF, g, S, E);
        {
            const int tid = hidden_tid(), lane = tid & 63;
            LAS float* red = (LAS float*)(F.lds + RING_OFF);
            const bf16* a = ACT + (size_t)(PADF + (lane & 15)) * DFF + 1376 * F.wave + 8 * (lane >> 4);
            for (int cb = blockIdx.x; cb < DM / 16; cb += F.G) {
                const int c0 = 16 * cb; const bf16* b = W1D + (size_t)(c0 + (lane & 15)) * DFF + 1376 * F.wave + 8 * (lane >> 4);
                const float sum = thin_reduce(red, thin16(a, b, 43), tid, lane, F.wave);
                if (tid < 256) { const int l = tid >> 2, tok = 4 * (l >> 4) + (tid & 3), col = l & 15; const float hv = meta[(size_t)tok * DM + c0 + col] + 0.5f * sum;
                    H[(size_t)(PADF + tok) * DM + c0 + col] = hv; XN[(size_t)(PADF + tok) * DM + c0 + col] = (bf16)f2bf(hv);
                    float sq = hv * hv; sq += __shfl_xor(sq, 4); sq += __shfl_xor(sq, 8); sq += __shfl_xor(sq, 16); sq += __shfl_xor(sq, 32);
                    if (col == 0) __hip_atomic_fetch_add(SS1 + PADF + tok, (unsigned long long)(sq * 16777216.0f), RLX_AGENT); }
            }
        }
        if (BOTH(2)) GRID_BAR();
    }
    if (IN(4)) {
        pg8::Gemm g{XN + (size_t)XR0 * DM, WIN, SEQ, NQKV, DM}; pg8::StaticOrder S; S.init(SEQ, NQKV, F.G, (int)blockIdx.x);
        pg8::EpiProj E{PROJ, (size_t)MP * HD, LOGIT, XR0, SS1};
        pg8::gemm_phase<pg8::EpiProj, pg8::StaticOrder, true, true>(F.lds + RING_OFF, g, S, E);
        {
            const int tid = hidden_tid(), lane = tid & 63;
            LAS float* red = (LAS float*)(F.lds + RING_OFF);
            const size_t CH = (size_t)MP * HD;
            constexpr int NTASK = 513 + SEQ / 16;
            f32x4 accs[5];
#pragma unroll
            for (int i = 0; i < 5; ++i) { const int t = (int)blockIdx.x + i * F.G; accs[i] = (f32x4){0.f, 0.f, 0.f, 0.f};
                if (t < NTASK) { int arow, brow; if (t < 512) { const int kc = t >> 3, chunk = kc < 32 ? 16 + kc : 32 + kc; arow = PADF; brow = chunk * 128 + (t & 7) * 16; }
                    else if (t == 512) { arow = PADF; brow = NQKV; } else { arow = XR0 + 16 * (t - 513); brow = NQKV; }
                    accs[i] = thin16(XN + (size_t)(arow + (lane & 15)) * DM + 512 * F.wave + 8 * (lane >> 4), WIN + (size_t)(brow + (lane & 15)) * DM + 512 * F.wave + 8 * (lane >> 4), 16); } }
#pragma unroll
            for (int i = 0; i < 5; ++i) *(LAS f32x4*)(red + (i * 8 + F.wave) * 256 + lane * 4) = accs[i];
            __syncthreads();
            if (tid < 256) {
#pragma unroll
                for (int i = 0; i < 5; ++i) { const int t = (int)blockIdx.x + i * F.G;
                    if (t < NTASK) { float sum = 0.f;
#pragma unroll
                        for (int w = 0; w < 8; ++w) sum += red[(i * 8 + w) * 256 + tid];
                        int arow, brow; if (t < 512) { const int kc = t >> 3, chunk = kc < 32 ? 16 + kc : 32 + kc; arow = PADF; brow = chunk * 128 + (t & 7) * 16; }
                        else if (t == 512) { arow = PADF; brow = NQKV; } else { arow = XR0 + 16 * (t - 513); brow = NQKV; }
                        const int l = tid >> 2, tok = 4 * (l >> 4) + (tid & 3), col = l & 15;
                        sum *= pg8::rstd_of(SS1, arow + tok, RMS_EPS);
                        if (t < 512) PROJ[(size_t)(brow >> 7) * CH + (size_t)(arow + tok) * HD + (brow & 127) + col] = (bf16)f2bf(sum);
                        else LOGIT[(size_t)(arow + tok) * 16 + col] = sum; } }
            }
            __syncthreads();
            for (int i = blockIdx.x * 512 + tid; i < 64 * 48 * 16; i += F.G * 512) { const int kc = i / (48 * 16), r = i - kc * (48 * 16), chunk = kc < 32 ? 16 + kc : 32 + kc;
                *(GAS v4u*)(PROJ + (size_t)chunk * CH + (size_t)192 * HD + r * 8) = (v4u){0u, 0u, 0u, 0u}; }
        }
        if (BOTH(4)) GRID_BAR();
    }
    if (IN(5)) {
        const int tid = hidden_tid(), lane = tid & 63; (void)tid; (void)lane;
        const int b = blockIdx.x;
        const float NEGINF = -__builtin_inff();
        if (b < 16) {
            LAS double* ds = (LAS double*)(F.lds + RING_OFF);
            const float bf = args.in[8][b];
            float val[17]; double loc = 0.0;
            const int r0 = PADF + 17 * tid;
#pragma unroll
            for (int i = 0; i < 17; ++i) { const int r = r0 + i; float v = 0.f;
                if (r < MP) { const float xl = LOGIT[(size_t)r * 16 + b] + bf; v = fminf(xl, 0.f) - log1pf(expf(-fabsf(xl))); }
                val[i] = v; loc += (double)v; }
            ds[tid] = loc; __syncthreads();
#pragma unroll 1
            for (int o = 1; o < 512; o <<= 1) { double t = 0.0; if (tid >= o) t = ds[tid - o]; __syncthreads(); ds[tid] += t; __syncthreads(); }
            double run = tid > 0 ? ds[tid - 1] : 0.0;
            float* dst = BIAS + (size_t)(8 + b) * MP;
#pragma unroll
            for (int i = 0; i < 17; ++i) { const int r = r0 + i; run += (double)val[i]; if (r < MP) dst[r] = (float)(-run * (double)INV_SCALE); }
            for (int r = tid; r < PADF; r += 512) dst[r] = NEGINF;
            __syncthreads();
        } else if (b < 24) {
            const int h = b - 16; const float slope = exp2f(-(float)(h + 1));
            float* dst = BIAS + (size_t)h * MP;
            for (int r = tid; r < MP; r += 512) dst[r] = r < PADF ? NEGINF : slope * (float)r * INV_SCALE;
        }
        {
            const size_t CH = (size_t)MP * HD;
            for (int it = (int)blockIdx.x - 24; it >= 0 && it < 64 * 33; it += F.G - 24) {
                const int ci = it / 33, rt = it - ci * 33, chunk = ci < 32 ? ci : ci + 16;
                const bool isq = ci < 16 || (ci >= 32 && ci < 48);
                const int row = rt * 256 + (tid >> 1);
                float ss = 0.f;
                if (row >= (isq ? XR0 : PADF)) { const GAS v4u* p = (const GAS v4u*)(PROJ + (size_t)chunk * CH + (size_t)row * HD + (tid & 1) * 64);
#pragma unroll
                    for (int j = 0; j < 8; ++j) { const v4u w = p[j]; const float a0 = bf_lo(w.x), a1 = bf_hi(w.x), a2 = bf_lo(w.y), a3 = bf_hi(w.y), a4 = bf_lo(w.z), a5 = bf_hi(w.z), a6 = bf_lo(w.w), a7 = bf_hi(w.w);
                        ss += ((a0 * a0 + a1 * a1) + (a2 * a2 + a3 * a3)) + ((a4 * a4 + a5 * a5) + (a6 * a6 + a7 * a7)); } }
                ss += __shfl_xor(ss, 1);
#pragma unroll
                for (int o = 2; o < 64; o <<= 1) ss = fmaxf(ss, __shfl_xor(ss, o));
                if (lane == 0) __hip_atomic_fetch_max((unsigned*)(F.ctl + CW_NORM + chunk), __builtin_bit_cast(unsigned, ss), RLX_AGENT);
            }
        }
        if (BOTH(5)) GRID_BAR();
    }
    if (IN(6)) {
        const int tid = hidden_tid(), lane = tid & 63; (void)lane;
        char* al = (char*)lds + RING_OFF;
        const size_t CH = (size_t)MP * HD;
        volatile LAS int* MQ = (volatile LAS int*)(F.lds + MISC_OFF) + 16;
        const int home = blockIdx.x & 7;
#define QLEN(q_) ((4 + ((q_) < 4 ? 1 : 3)) * 32)
#define ATT_POP(dst_) do { int code_ = -1;                                                                                                 \
            for (int k_ = 0; k_ < 8; ++k_) { const int q_ = (home + k_) & 7;                                                               \
                const unsigned idx_ = __hip_atomic_fetch_add((unsigned*)(F.ctl + CW_QUEUE + 64 * q_), 1u, RLX_AGENT);                      \
                if (idx_ < (unsigned)QLEN(q_)) { code_ = q_ * 256 + (int)idx_; break; } }                                                  \
            dst_ = code_; } while (0)
#define ATT_REF(R_, code_) do { const int q_ = (code_) >> 8, i_ = (code_) & 255; int vh_, qb_;                                              \
            if (i_ < 128) { const int ii_ = i_ & 63, h_ = (i_ < 64) ? 4 + (q_ >> 1) : 3 - (q_ >> 1); vh_ = 4 * h_ + 2 * (q_ & 1) + (ii_ & 1); qb_ = 32 - (ii_ >> 1); } \
            else { const int ii_ = i_ - 128, nf_ = q_ < 4 ? 1 : 3, f_ = ii_ % nf_; qb_ = 32 - ii_ / nf_; vh_ = 32 + (q_ < 4 ? q_ : 4 + 3 * (q_ - 4) + f_); }  \
            int qc_, kc_, vc_, bi_; att::bf16* ob_;                                                                                         \
            if (vh_ < 32) { const int h_ = vh_ >> 2, c_ = (vh_ >> 1) & 1, hf_ = vh_ & 1; qc_ = 2 * h_ + c_; kc_ = 16 + 2 * h_ + c_; vc_ = 32 + 2 * h_ + hf_; bi_ = h_; \
                            ob_ = (c_ ? O1B : OB) + h_ * 256 + hf_ * 128; }                                                                \
            else { const int h_ = vh_ - 32; qc_ = 48 + h_; kc_ = 64 + h_; vc_ = 80 + h_; bi_ = 8 + h_; ob_ = OB + 2048 + h_ * 128; }        \
            R_.Q = PROJ + (size_t)qc_ * CH + (size_t)qb_ * 256 * HD; R_.K = PROJ + (size_t)kc_ * CH; R_.V = PROJ + (size_t)vc_ * CH;        \
            R_.O = ob_ + (size_t)qb_ * 256 * DM; R_.P0 = qb_ * 256;                                                                         \
            const float* bt_ = BIAS + (size_t)bi_ * MP;                                                                                     \
            const float qn_ = __builtin_bit_cast(float, __hip_atomic_load((unsigned*)(F.ctl + CW_NORM + qc_), RLX_AGENT));                   \
            const float kn_ = __builtin_bit_cast(float, __hip_atomic_load((unsigned*)(F.ctl + CW_NORM + kc_), RLX_AGENT));                   \
            const float c0_ = 2.0f * sqrtf(qn_ * kn_) * 1.002f - bt_[R_.P0];                                                               \
            const int ln_ = hidden_tid() & 63, j1_ = 3 + ln_, j2_ = 67 + ln_, je_ = 4 * qb_;                                                                       \
            const bool ns1_ = j1_ < je_ ? !((c0_ + bt_[64 * j1_ + 63]) * (att::SCALE * 1.4426950408889634f) < -160.0f) : true;              \
            const bool ns2_ = j2_ < je_ ? !((c0_ + bt_[64 * j2_ + 63]) * (att::SCALE * 1.4426950408889634f) < -160.0f) : true;              \
            const unsigned long long m1_ = __ballot(ns1_), m2_ = __ballot(ns2_);                                                            \
            int jl_ = m1_ ? 3 + __builtin_ctzll(m1_) : (m2_ ? 67 + __builtin_ctzll(m2_) : je_); if (jl_ > je_) jl_ = je_;                  \
            R_.jlo = __builtin_amdgcn_readfirstlane(jl_); R_##_bias = bt_; } while (0)
#define ATT_BIAS(R_) do { for (int i_ = 16 * R_.jlo + tid; i_ < (R_.P0 + 256) / 4; i_ += 512) *(f32x4*)(al + att::BIAS_OFF + 16 * i_) = *(const f32x4*)(R_##_bias + 4 * i_); } while (0)
        if (tid == 0) { int c0, c1; ATT_POP(c0); if (c0 >= 0) ATT_POP(c1); else c1 = -1; MQ[0] = c0; MQ[2] = c1; }
        __syncthreads();
        const int c_first = MQ[0]; int c_nxt = MQ[2];
        if (c_first >= 0) {
            att::Seam S; att::BlockRef cur, nxt; const float* cur_bias; const float* nxt_bias;
            ATT_REF(cur, c_first);
            ATT_BIAS(cur);
            att::attn_prime(cur, al, S);
            for (;;) {
                const bool last = c_nxt < 0;
                if (!last) ATT_REF(nxt, c_nxt); else { nxt = cur; nxt_bias = cur_bias; }
                if (tid == 0) { int c2 = -1; if (!last) ATT_POP(c2); MQ[0] = c2; }
                att::attn_block(cur, nxt, al, S);
                if (last) break;
                cur = nxt; cur_bias = nxt_bias; c_nxt = MQ[0];
                ATT_BIAS(cur); __syncthreads();
            }
        }
#undef QLEN
#undef ATT_POP
#undef ATT_REF
#undef ATT_BIAS
        if (BOTH(6)) GRID_BAR();
    }
    if (IN(7)) {
        const int tid = hidden_tid(), lane = tid & 63; (void)tid; (void)lane;
        float lam;
        { const float* q1 = args.in[9]; const float* k1 = args.in[10]; const float* q2 = args.in[11]; const float* k2 = args.in[12];
          const float s1 = wave_sum(q1[lane] * k1[lane] + q1[lane + 64] * k1[lane + 64]);
          const float s2 = wave_sum(q2[lane] * k2[lane] + q2[lane + 64] * k2[lane + 64]);
          lam = expf(s1) - expf(s2) + LAMBDA_INIT; }
        const f32x4 gn = *(const f32x4*)(args.in[13] + 4 * lane);
        for (int m = XR0 + gw; m < MP; m += NGW) {
            GAS v2u* o0 = (GAS v2u*)(OB + (size_t)m * DM) + lane; const GAS v2u* o1 = (const GAS v2u*)(O1B + (size_t)m * DM) + lane;
            v2u a[8], c[8];
#pragma unroll
            for (int h = 0; h < 8; ++h) { a[h] = o0[64 * h]; c[h] = o1[64 * h]; }
#pragma unroll
            for (int h = 0; h < 8; ++h) {
                const float x0 = bf_lo(a[h].x) - lam * bf_lo(c[h].x), x1 = bf_hi(a[h].x) - lam * bf_hi(c[h].x), x2 = bf_lo(a[h].y) - lam * bf_lo(c[h].y), x3 = bf_hi(a[h].y) - lam * bf_hi(c[h].y);
                const float ss = wave_sum((x0 * x0 + x1 * x1) + (x2 * x2 + x3 * x3));
                const float r = 1.0f / sqrtf(ss * (1.0f / 256.0f) + SUBLN_EPS);
                v2u w; w.x = pk2(x0 * r * gn.x * (1.0f - LAMBDA_INIT), x1 * r * gn.y * (1.0f - LAMBDA_INIT)); w.y = pk2(x2 * r * gn.z * (1.0f - LAMBDA_INIT), x3 * r * gn.w * (1.0f - LAMBDA_INIT));
                o0[64 * h] = w; }
        }
        if (BOTH(7)) GRID_BAR();
    }
    if (IN(8)) {
        pg8::Gemm g{OB + (size_t)XR0 * DM, WOUT, SEQ, DM, DM}; pg8::StaticOrder S; S.init(SEQ, DM, F.G, (int)blockIdx.x);
        pg8::EpiResid<true> E{H, 0, H, DM, 1.0f, XR0, XN, SS2};
        pg8::gemm_phase<pg8::EpiResid<true>, pg8::StaticOrder, true, true>(F.lds + RING_OFF, g, S, E);
        if (BOTH(8)) GRID_BAR();
    }
    if (IN(10)) {
        pg8::Gemm g{XN + (size_t)XR0 * DM, W2GU, SEQ, NGU, DM}; pg8::StaticOrder S; S.init(SEQ, NGU, F.G, (int)blockIdx.x);
        pg8::EpiSwiGLU E{ACT, DFF, XR0, SS2};
        pg8::gemm_phase<pg8::EpiSwiGLU, pg8::StaticOrder, true, true>(F.lds + RING_OFF, g, S, E);
        { const int tid = hidden_tid(), lane = tid & 63; (void)tid;
          CONV_STREAM(CW_CONVQ2, NITEMS - I_D, I_D); }
        if (BOTH(10)) GRID_BAR();
    }
    if (IN(11)) {
        pg8::Gemm g{ACT + (size_t)XR0 * DFF, W2D, SEQ, DM, DFF}; pg8::StaticOrder S; S.init(SEQ, DM, F.G, (int)blockIdx.x);
        pg8::EpiResid<false> E{H, 0, H, DM, 0.5f, XR0, nullptr, nullptr};
        pg8::gemm_phase<pg8::EpiResid<false>, pg8::StaticOrder, true, true>(F.lds + RING_OFF, g, S, E);
        if (BOTH(11)) GRID_BAR();
    }
    if (IN(12)) {
        const int tid = hidden_tid(), lane = tid & 63; (void)tid;
        const GAS f32x4* gr = (const GAS f32x4*)args.in[19] + lane;
        f32x4 gg[16];
#pragma unroll
        for (int j = 0; j < 16; ++j) gg[j] = gr[64 * j];
#define P12_LOAD(V_, m_) do { const GAS f32x4* xr_ = (const GAS f32x4*)(H + (size_t)(m_) * DM) + lane; _Pragma("unroll") for (int j = 0; j < 16; ++j) V_[j] = __builtin_nontemporal_load(xr_ + 64 * j); } while (0)
#define P12_STORE(V_, m_) do { float s_ = 0.f; _Pragma("unroll") for (int j = 0; j < 16; ++j) s_ += (V_[j].x * V_[j].x + V_[j].y * V_[j].y) + (V_[j].z * V_[j].z + V_[j].w * V_[j].w);   \
            const float r_ = 1.0f / sqrtf(wave_sum(s_) * (1.0f / DM) + RMS_EPS); GAS f32x4* o_ = (GAS f32x4*)(args.out + (size_t)((m_) - XR0) * DM) + lane;                      \
            _Pragma("unroll") for (int j = 0; j < 16; ++j) { f32x4 w_; w_.x = V_[j].x * r_ * gg[j].x; w_.y = V_[j].y * r_ * gg[j].y; w_.z = V_[j].z * r_ * gg[j].z; w_.w = V_[j].w * r_ * gg[j].w; \
                __builtin_nontemporal_store(w_, o_ + 64 * j); } } while (0)
        f32x4 va[16], vb[16];
        int m = XR0 + gw;
        if (m < MP) {
            P12_LOAD(va, m);
            for (;;) {
                const int mn = m + NGW;
                if (mn < MP) P12_LOAD(vb, mn);
                P12_STORE(va, m);
                if (mn >= MP) break;
                const int m2 = mn + NGW;
                if (m2 < MP) P12_LOAD(va, m2);
                P12_STORE(vb, mn);
                if (m2 >= MP) break;
                m = m2;
            }
        }
#undef P12_LOAD
#undef P12_STORE
    }
#undef IN
#undef BOTH
#undef GRID_BAR
}

extern "C" void kernel_launch(void* const* d_in, const int* in_sizes, int n_in, void* d_out, int out_size, void* d_ws, size_t ws_size, hipStream_t stream) {
    static int grid = 0;
    if (grid == 0) {
        if (n_in != 20 || in_sizes[0] != SEQ * DM || out_size != SEQ * DM || ws_size < WS_END) { fprintf(stderr, "kernel_launch: shape / workspace mismatch: n_in %d in0 %d out %d ws %zu (need %zu)\n", n_in, n_in > 0 ? in_sizes[0] : -1, out_size, ws_size, (size_t)WS_END); grid = -1; return; }
        int dev = 0, cus = 0, per_cu = 0;
        if (hipGetDevice(&dev) != hipSuccess || hipDeviceGetAttribute(&cus, hipDeviceAttributeMultiprocessorCount, dev) != hipSuccess) { grid = -1; return; }
        if (hipFuncSetAttribute((const void*)hymba_fwd, hipFuncAttributeMaxDynamicSharedMemorySize, LDS_BYTES) != hipSuccess) { fprintf(stderr, "kernel_launch: hipFuncSetAttribute failed\n"); grid = -1; return; }
        if (hipOccupancyMaxActiveBlocksPerMultiprocessor(&per_cu, (const void*)hymba_fwd, NWAVES * 64, LDS_BYTES) != hipSuccess || per_cu < 1) { fprintf(stderr, "kernel_launch: occupancy query reports %d\n", per_cu); }
        (void)hipGetLastError();
        grid = cus;
        if (grid * 5 < 513 + SEQ / 16 || grid % 8 != 0) { fprintf(stderr, "kernel_launch: built for a 256-CU device (grid %d)\n", grid); grid = -1; return; }
    }
    if (grid < 0) return;
    if (hipMemsetAsync((char*)d_ws + WS_CTL, 0, CTL_ZERO_BYTES, stream) != hipSuccess) return;
    Args a{};
    for (int i = 0; i < 20; ++i) a.in[i] = (const float*)d_in[i];
    a.out = (float*)d_out; a.ws = (unsigned char*)d_ws;
#if defined(PROBE_PHASE)
    a.ph_lo = 0; a.ph_hi = PROBE_PHASE + 1; hipLaunchKernelGGL(hymba_fwd, dim3(grid), dim3(NWAVES * 64), LDS_BYTES, stream, a);
    if (hipMemsetAsync((char*)d_ws + WS_CTL + CW_BAR * 4, 0, (CW_QUEUE + 8 * 64 - CW_BAR) * 4, stream) != hipSuccess) return;
    a.ph_lo = PROBE_PHASE; a.ph_hi = N_PHASES; hipLaunchKernelGGL(hymba_fwd, dim3(grid), dim3(NWAVES * 64), LDS_BYTES, stream, a);
#else
    if (N_LAUNCHES == 1) { a.ph_lo = 0; a.ph_hi = N_PHASES; hipLaunchKernelGGL(hymba_fwd, dim3(grid), dim3(NWAVES * 64), LDS_BYTES, stream, a); }
    else for (int p = 0; p < N_PHASES; ++p) { a.ph_lo = p; a.ph_hi = p + 1; hipLaunchKernelGGL(hymba_fwd, dim3(grid), dim3(NWAVES * 64), LDS_BYTES, stream, a); }
#endif
}
```

```cpp
#include <hip/hip_runtime.h>
#include <cstdio>
#include <cstdint>
#ifndef MK_N_LAUNCHES
#define MK_N_LAUNCHES 1
#endif
namespace pg8 {
#define PG8_LAS __attribute__((address_space(3)))
typedef unsigned short bf16_t;
typedef short bf16x8 __attribute__((ext_vector_type(8)));
typedef float f32x4 __attribute__((ext_vector_type(4)));
typedef unsigned u32x4 __attribute__((ext_vector_type(4)));
constexpr int BM = 256, BK = 64, HALF = 128, HTB = HALF * BK * 2  , STAGE_BYTES = 8 * HTB, NXCD = 8, WGM = 8;

__host__ __device__ __forceinline__ int lds_byte(int r, int c) { const int st = (r >> 4) * 2 + (c >> 5), rr = r & 15, cc = c & 31, ob = rr * 64 + cc * 2; return st * 1024 + (ob ^ (((ob >> 9) & 1) << 5)); }
__host__ __device__ __forceinline__ void stage_rc(int b, int& R, int& C) { const int st = b / 1024, sb = b % 1024, swz = sb ^ (((sb >> 9) & 1) << 5); R = (st >> 1) * 16 + swz / 64; C = (st & 1) * 32 + (swz % 64) / 2; }
__host__ __device__ __forceinline__ int perm32(int rho) { const int n = rho >> 4, i = rho & 15; return 8 * (i >> 2) + 4 * n + (i & 3); }

struct Unit { int pm, pn; };
struct Gemm { const bf16_t* A; const bf16_t* Bt; int M, N, K; };

struct StaticOrder {
    int nM, nN, nwg, G, c;
    __host__ __device__ void init(int M, int N, int G_, int c_) { nM = M / BM; nN = N / BM; nwg = nM * nN; G = G_; c = c_; }
    __host__ __device__ bool next(int i, Unit& u) const {
        const long L = (long)i * G + c; if (L >= nwg) return false;
        int wgid = (int)L; { const int q = nwg / NXCD, r = nwg % NXCD, xcd = wgid % NXCD, off = wgid / NXCD; wgid = (xcd < r ? xcd * (q + 1) : r * (q + 1) + (xcd - r) * q) + off; }
        const int nig = WGM * nN, gid = wgid / nig, fm = gid * WGM, gsz = (nM - fm) < WGM ? (nM - fm) : WGM;
        u.pm = fm + ((wgid % nig) % gsz); u.pn = (wgid % nig) / gsz; return true;
    }
    __device__ __forceinline__ void a_ready(const Unit&) const {}
    __device__ __forceinline__ void done(const Unit&) const {}
};

__device__ __forceinline__ unsigned cvt_pk_bf16(float lo, float hi) { unsigned r; asm volatile("v_cvt_pk_bf16_f32 %0, %1, %2" : "=v"(r) : "v"(lo), "v"(hi)); return r; }
__device__ __forceinline__ float silu_mul(float g, float u) { const float e = __builtin_amdgcn_exp2f(g * -1.4426950408889634f); return g * __builtin_amdgcn_rcpf(1.0f + e) * u; }

__device__ __forceinline__ float rstd_of(const unsigned long long* ss, int row, float eps) {
    const unsigned long long v = ss[row];
    return 1.0f / sqrtf((float)v * (1.0f / (16777216.0f * 4096.0f)) + eps);
}
__device__ __forceinline__ float rstd_from(unsigned long long v, float eps) { return 1.0f / sqrtf((float)v * (1.0f / (16777216.0f * 4096.0f)) + eps); }
struct EpiSwiGLU {
    static constexpr bool PERM = true, AFTER_DRAIN = false;
    bf16_t* O; int ldc; int row_off; const unsigned long long* ss;
    __device__ __forceinline__ void operator()(const f32x4 (&acc)[2][2][4][2], const Unit& u, int wr, int wc, int fr, int fq) const {
        const int row0 = row_off + u.pm * BM + wr * 64 + fr, col0 = u.pn * HALF + wc * 32 + 8 * fq;
        unsigned long long sv[2][4];
#pragma unroll
        for (int ai = 0; ai < 2; ++ai)
#pragma unroll
            for (int m = 0; m < 4; ++m) sv[ai][m] = ss[row0 + ai * HALF + m * 16];
#pragma unroll
        for (int ai = 0; ai < 2; ++ai)
#pragma unroll
            for (int m = 0; m < 4; ++m) { bf16_t* rowp = O + (size_t)(row0 + ai * HALF + m * 16) * ldc + col0;
                const float rs = rstd_from(sv[ai][m], 1e-6f);
                const f32x4 g0 = acc[ai][0][m][0] * rs, g1 = acc[ai][0][m][1] * rs, u0 = acc[ai][1][m][0] * rs, u1 = acc[ai][1][m][1] * rs;
                u32x4 w; w.x = cvt_pk_bf16(silu_mul(g0[0], u0[0]), silu_mul(g0[1], u0[1])); w.y = cvt_pk_bf16(silu_mul(g0[2], u0[2]), silu_mul(g0[3], u0[3]));
                w.z = cvt_pk_bf16(silu_mul(g1[0], u1[0]), silu_mul(g1[1], u1[1])); w.w = cvt_pk_bf16(silu_mul(g1[2], u1[2]), silu_mul(g1[3], u1[3]));
                *(u32x4*)rowp = w; }
    }
};
template <bool XN> struct EpiResid {
    static constexpr bool PERM = false, AFTER_DRAIN = false;
    const float* base; int shift; float* out; int ldc; float alpha; int row_off; bf16_t* xn; unsigned long long* ssout;
    __device__ __forceinline__ void operator()(const f32x4 (&acc)[2][2][4][2], const Unit& u, int wr, int wc, int fr, int fq) const {
        typedef unsigned u32x2v __attribute__((ext_vector_type(2)));
        const int row0 = row_off + u.pm * BM + wr * 64 + fr, col0 = u.pn * BM + wc * 32 + 4 * fq;
#pragma unroll
        for (int ai = 0; ai < 2; ++ai) {
            f32x4 b[4][2][2];
#pragma unroll
            for (int m = 0; m < 4; ++m) { const float* brow = base + (size_t)(row0 + ai * HALF + m * 16 - shift) * ldc + col0;
#pragma unroll
                for (int bj = 0; bj < 2; ++bj)
#pragma unroll
                    for (int n = 0; n < 2; ++n) b[m][bj][n] = *(const f32x4*)(brow + bj * HALF + n * 16); }
#pragma unroll
            for (int m = 0; m < 4; ++m) { const int r = row0 + ai * HALF + m * 16; float* orow = out + (size_t)r * ldc + col0; float sq = 0.f;
#pragma unroll
                for (int bj = 0; bj < 2; ++bj)
#pragma unroll
                    for (int n = 0; n < 2; ++n) { const f32x4 o = b[m][bj][n] + acc[ai][bj][m][n] * alpha; *(f32x4*)(orow + bj * HALF + n * 16) = o;
                        if (XN) { u32x2v w; w.x = cvt_pk_bf16(o[0], o[1]); w.y = cvt_pk_bf16(o[2], o[3]); *(u32x2v*)(xn + (size_t)r * ldc + col0 + bj * HALF + n * 16) = w;
                            sq += (o[0] * o[0] + o[1] * o[1]) + (o[2] * o[2] + o[3] * o[3]); } }
                if (XN) { sq += __shfl_xor(sq, 16); sq += __shfl_xor(sq, 32);
                    if (fq == 0) __hip_atomic_fetch_add(ssout + r, (unsigned long long)(sq * 16777216.0f), __ATOMIC_RELAXED, __HIP_MEMORY_SCOPE_AGENT); } }
        }
    }
};
struct EpiProj {
    static constexpr bool PERM = true, AFTER_DRAIN = false;
    bf16_t* P; size_t chunk_stride; float* logit; int row_off; const unsigned long long* ss;
    __device__ __forceinline__ void operator()(const f32x4 (&acc)[2][2][4][2], const Unit& u, int wr, int wc, int fr, int fq) const {
        const int row0 = row_off + u.pm * BM + wr * 64 + fr;
        if (u.pn < 48) {
            unsigned long long sv[2][4];
#pragma unroll
            for (int ai = 0; ai < 2; ++ai)
#pragma unroll
                for (int m = 0; m < 4; ++m) sv[ai][m] = ss[row0 + ai * HALF + m * 16];
#pragma unroll
            for (int ai = 0; ai < 2; ++ai)
#pragma unroll
                for (int m = 0; m < 4; ++m) { const int r = row0 + ai * HALF + m * 16; const float rs = rstd_from(sv[ai][m], 1e-6f);
#pragma unroll
                    for (int bj = 0; bj < 2; ++bj) { bf16_t* dst = P + (size_t)(2 * u.pn + bj) * chunk_stride + (size_t)r * 128 + wc * 32 + 8 * fq;
                        const f32x4 v0 = acc[ai][bj][m][0] * rs, v1 = acc[ai][bj][m][1] * rs;
                        u32x4 w; w.x = cvt_pk_bf16(v0[0], v0[1]); w.y = cvt_pk_bf16(v0[2], v0[3]); w.z = cvt_pk_bf16(v1[0], v1[1]); w.w = cvt_pk_bf16(v1[2], v1[3]);
                        *(u32x4*)dst = w; } }
        } else if (wc == 0 && fq < 2) {
#pragma unroll
            for (int ai = 0; ai < 2; ++ai)
#pragma unroll
                for (int m = 0; m < 4; ++m) { const int r = row0 + ai * HALF + m * 16;
#pragma unroll
                    for (int n = 0; n < 2; ++n) *(f32x4*)(logit + (size_t)r * 16 + 8 * fq + 4 * n) = acc[ai][0][m][n]; }
        }
    }
};
template <class Epi, class Sched, bool ALIGN_EPI = false, bool SP2 = false>
__device__ __forceinline__ void gemm_phase(PG8_LAS unsigned char* lds, const Gemm g, const Sched& S, const Epi& E) {
    const int tid = threadIdx.x, wid = __builtin_amdgcn_readfirstlane(tid >> 6), lane = tid & 63, wr = wid >> 2, wc = wid & 3, fr = lane & 15, fq = lane >> 4;
    const int K = g.K, nt = K / BK;
    unsigned voffA[2], voffB[2];
#pragma unroll
    for (int i = 0; i < 2; ++i) { int R, C; stage_rc(tid * 16 + i * 8192, R, C); const int Rb = Epi::PERM ? ((R & ~31) + perm32(R & 31)) : R;
        voffA[i] = (unsigned)(R * K + C) * 2u; voffB[i] = (unsigned)(Rb * K + C) * 2u; }
    const size_t kstep = (size_t)(BK * 2);
    const size_t hstep = (size_t)HALF * K * 2;
    const size_t tstep = 2 * hstep;
    const unsigned ldsw = (unsigned)wid * 1024u;
    const int aoff = lds_byte(wr * 64 + fr, fq * 8), boff = lds_byte(wc * 32 + fr, fq * 8);
#define PG8_SA(b, h) (((b) * 2 + (h)) * HTB)
#define PG8_SB(b, h) ((4 + (b) * 2 + (h)) * HTB)
#define PG8_STAGE(bufoff, gbase, voff) do { _Pragma("unroll") for (int _i = 0; _i < 2; ++_i) \
        __builtin_amdgcn_global_load_lds((const unsigned*)((const char*)(gbase) + (voff)[_i]), (PG8_LAS unsigned*)(lds + (bufoff) + ldsw + _i * 8192), 16, 0, 0); } while (0)
#define PG8_LDA(dst, b, h) do { _Pragma("unroll") for (int m = 0; m < 4; ++m) _Pragma("unroll") for (int k = 0; k < 2; ++k) dst[m][k] = *(const PG8_LAS bf16x8*)(lds + PG8_SA(b, h) + aoff + m * 2048 + k * 1024); } while (0)
#define PG8_LDB(dst, b, h) do { _Pragma("unroll") for (int n = 0; n < 2; ++n) _Pragma("unroll") for (int k = 0; k < 2; ++k) dst[n][k] = *(const PG8_LAS bf16x8*)(lds + PG8_SB(b, h) + boff + n * 2048 + k * 1024); } while (0)
#define PG8_MMA(ai, bj, At, Bt) do { __builtin_amdgcn_s_setprio(1); _Pragma("unroll") for (int m = 0; m < 4; ++m) _Pragma("unroll") for (int n = 0; n < 2; ++n) _Pragma("unroll") for (int k = 0; k < 2; ++k) \
        acc[ai][bj][m][n] = __builtin_amdgcn_mfma_f32_16x16x32_bf16(Bt[n][k], At[m][k], acc[ai][bj][m][n], 0, 0, 0); __builtin_amdgcn_s_setprio(0); } while (0)
#define PG8_WAIT_V(n) asm volatile("s_waitcnt vmcnt(" #n ")" ::: "memory")
#define PG8_WAIT_L(n) asm volatile("s_waitcnt lgkmcnt(" #n ")" ::: "memory")
#define PG8_BAR __builtin_amdgcn_s_barrier()
#define PG8_SCHED __builtin_amdgcn_sched_barrier(0)
    Unit cur, nxt; int ui = 0;
    if (!S.next(0, cur)) return;
    f32x4 acc[2][2][4][2];
#pragma unroll
    for (int a = 0; a < 2; ++a)
#pragma unroll
        for (int b = 0; b < 2; ++b)
#pragma unroll
            for (int m = 0; m < 4; ++m)
#pragma unroll
                for (int n = 0; n < 2; ++n) acc[a][b][m][n] = (f32x4){0.f, 0.f, 0.f, 0.f};
    bf16x8 At[4][2], B0[2][2], B1[2][2];
    const char* cA = (const char*)g.A + (size_t)cur.pm * tstep; const char* cB = (const char*)g.Bt + (size_t)cur.pn * tstep;
    S.a_ready(cur);
    if constexpr (SP2) {
        PG8_STAGE(PG8_SB(0, 0), cB, voffB); PG8_STAGE(PG8_SB(0, 1), cB + hstep, voffB); PG8_STAGE(PG8_SA(0, 0), cA, voffA); PG8_STAGE(PG8_SA(0, 1), cA + hstep, voffA);
        if (wr == 1) PG8_BAR;
        PG8_WAIT_V(2); PG8_BAR;
        PG8_STAGE(PG8_SB(1, 0), cB + kstep, voffB); PG8_STAGE(PG8_SA(1, 0), cA + kstep, voffA); PG8_STAGE(PG8_SB(1, 1), cB + hstep + kstep, voffB);
        PG8_WAIT_V(6); PG8_BAR;
    } else {
        PG8_STAGE(PG8_SB(0, 0), cB, voffB); PG8_STAGE(PG8_SA(0, 0), cA, voffA); PG8_STAGE(PG8_SB(0, 1), cB + hstep, voffB); PG8_STAGE(PG8_SA(0, 1), cA + hstep, voffA);
        if (wr == 1) PG8_BAR;
        PG8_WAIT_V(4); PG8_BAR;
        PG8_STAGE(PG8_SB(1, 0), cB + kstep, voffB); PG8_STAGE(PG8_SA(1, 0), cA + kstep, voffA); PG8_STAGE(PG8_SB(1, 1), cB + hstep + kstep, voffB);
        PG8_WAIT_V(6); PG8_BAR;
    }
    for (;;) {
        const bool has_next = S.next(ui + 1, nxt);
        const char* nA = has_next ? (const char*)g.A + (size_t)nxt.pm * tstep : cA; const char* nB = has_next ? (const char*)g.Bt + (size_t)nxt.pn * tstep : cB;
        for (int t = 0; t < nt; t += 2) {
            const bool last = (t == nt - 2);
            const char* a1 = cA + (size_t)(t + 1) * kstep;
            const char* a2 = last ? nA : cA + (size_t)(t + 2) * kstep; const char* b2 = last ? nB : cB + (size_t)(t + 2) * kstep;
            const char* a3 = a2 + kstep; const char* b3 = b2 + kstep;
            if (last && has_next) S.a_ready(nxt);
            if constexpr (SP2) {
            PG8_LDB(B0, 0, 0); PG8_LDB(B1, 0, 1); PG8_SCHED; PG8_LDA(At, 0, 0); PG8_STAGE(PG8_SA(1, 1), a1 + hstep, voffA);
            PG8_WAIT_V(8); PG8_WAIT_L(0); PG8_BAR; PG8_MMA(0, 0, At, B0); PG8_MMA(0, 1, At, B1); PG8_BAR; PG8_SCHED;
            PG8_LDA(At, 0, 1); PG8_STAGE(PG8_SB(0, 0), b2, voffB); PG8_STAGE(PG8_SB(0, 1), b2 + hstep, voffB); PG8_STAGE(PG8_SA(0, 0), a2, voffA);
            PG8_WAIT_V(8); PG8_WAIT_L(0); PG8_BAR; PG8_MMA(1, 0, At, B0); PG8_MMA(1, 1, At, B1); PG8_BAR; PG8_SCHED;
            PG8_LDB(B0, 1, 0); PG8_LDB(B1, 1, 1); PG8_SCHED; PG8_LDA(At, 1, 0); PG8_STAGE(PG8_SA(0, 1), a2 + hstep, voffA);
            PG8_WAIT_V(8); PG8_WAIT_L(0); PG8_BAR; PG8_MMA(0, 0, At, B0); PG8_MMA(0, 1, At, B1); PG8_BAR; PG8_SCHED;
            PG8_LDA(At, 1, 1); PG8_STAGE(PG8_SB(1, 0), b3, voffB); PG8_STAGE(PG8_SB(1, 1), b3 + hstep, voffB); PG8_STAGE(PG8_SA(1, 0), a3, voffA);
            PG8_WAIT_V(8); PG8_WAIT_L(0); PG8_BAR; PG8_MMA(1, 0, At, B0); PG8_MMA(1, 1, At, B1); PG8_BAR; PG8_SCHED;
            } else {
            PG8_LDB(B0, 0, 0); PG8_SCHED; PG8_LDA(At, 0, 0); PG8_STAGE(PG8_SA(1, 1), a1 + hstep, voffA);
            PG8_WAIT_L(8); PG8_BAR; PG8_WAIT_L(0); PG8_MMA(0, 0, At, B0); PG8_BAR; PG8_SCHED;
            PG8_LDB(B1, 0, 1); PG8_STAGE(PG8_SB(0, 0), b2, voffB);
            PG8_BAR; PG8_WAIT_L(0); PG8_MMA(0, 1, At, B1); PG8_BAR;
            PG8_LDA(At, 0, 1); PG8_STAGE(PG8_SA(0, 0), a2, voffA);
            PG8_BAR; PG8_WAIT_L(0); PG8_MMA(1, 0, At, B0); PG8_BAR; PG8_SCHED;
            PG8_STAGE(PG8_SB(0, 1), b2 + hstep, voffB);
            PG8_WAIT_V(6); PG8_BAR; PG8_MMA(1, 1, At, B1); PG8_BAR;
            PG8_LDB(B0, 1, 0); PG8_SCHED; PG8_LDA(At, 1, 0); PG8_STAGE(PG8_SA(0, 1), a2 + hstep, voffA);
            PG8_WAIT_L(8); PG8_BAR; PG8_WAIT_L(0); PG8_MMA(0, 0, At, B0); PG8_BAR; PG8_SCHED;
            PG8_LDB(B1, 1, 1); PG8_STAGE(PG8_SB(1, 0), b3, voffB);
            PG8_BAR; PG8_WAIT_L(0); PG8_MMA(0, 1, At, B1); PG8_BAR;
            PG8_LDA(At, 1, 1); PG8_STAGE(PG8_SA(1, 0), a3, voffA);
            PG8_BAR; PG8_WAIT_L(0); PG8_MMA(1, 0, At, B0); PG8_BAR; PG8_SCHED;
            PG8_STAGE(PG8_SB(1, 1), b3 + hstep, voffB);
            PG8_WAIT_V(6); PG8_BAR; PG8_MMA(1, 1, At, B1); PG8_BAR;
            }
        }
        if constexpr (ALIGN_EPI) { if (wr == 0) PG8_BAR; }
        if constexpr (!Epi::AFTER_DRAIN) { E(acc, cur, wr, wc, fr, fq); S.done(cur); }
        if (!has_next) break;
#pragma unroll
        for (int a = 0; a < 2; ++a)
#pragma unroll
            for (int b = 0; b < 2; ++b)
#pragma unroll
                for (int m = 0; m < 4; ++m)
#pragma unroll
                    for (int n = 0; n < 2; ++n) acc[a][b][m][n] = (f32x4){0.f, 0.f, 0.f, 0.f};
        cur = nxt; cA = nA; cB = nB; ++ui;
        if constexpr (ALIGN_EPI) { if (wr == 1) PG8_BAR; }
    }
    PG8_WAIT_V(0);
    if constexpr (!ALIGN_EPI) { if (wr == 0) PG8_BAR; }
    PG8_BAR;
    if constexpr (Epi::AFTER_DRAIN) { E.fused(acc, cur, wr, wc, fr, fq, lds, wid, lane); S.done(cur); }
#undef PG8_SA
#undef PG8_SB
#undef PG8_STAGE
#undef PG8_LDA
#undef PG8_LDB
#undef PG8_MMA
#undef PG8_WAIT_V
#undef PG8_WAIT_L
#undef PG8_BAR
#undef PG8_SCHED
}
}

namespace att {
typedef unsigned short bf16;
typedef short bf16x8 __attribute__((ext_vector_type(8)));
typedef short s16x4 __attribute__((ext_vector_type(4)));
typedef float f32x16 __attribute__((ext_vector_type(16)));
typedef float f32x4 __attribute__((ext_vector_type(4)));
typedef unsigned u32x4 __attribute__((ext_vector_type(4)));
constexpr int D = 128;
constexpr float SCALE = 0.08838834764831845f;
constexpr float THR = 8.f;
constexpr int NW = 8, QBLK = 32, KVBLK = 64, QB = NW * QBLK;
constexpr int SHM_V = KVBLK * D * 2, SHM_K = KVBLK * D * 2;
constexpr int WS_OFF = 2 * SHM_V + 2 * SHM_K;
constexpr int BIAS_OFF = WS_OFF + NW * 64 * 4;
constexpr int BIAS_N = 8448;
constexpr int ATT_LDS_BYTES = BIAS_OFF + BIAS_N * 4;
constexpr int J_LO = 3;
constexpr unsigned WBIG = 1u << 30;
constexpr int OP = 4096;

#define KSWZ(row, colB) ((row) * 256 + ((colB) ^ (((row) & 7) << 4)))
#define SBAR() __builtin_amdgcn_sched_barrier(0)
__device__ __forceinline__ int v_st(int k, int c) { const int kk = (k & ~0xC) | ((k & 4) << 1) | ((k & 8) >> 1); return ((kk >> 3) * 4 + (c >> 5)) * 512 + ((kk & 7) * 32 + (c & 31)) * 2; }
__device__ __forceinline__ int v_rd_base(int lane) { return ((lane & 3) << 3) | (((lane >> 2) & 3) << 6) | (((lane >> 4) & 1) << 5) | (((lane >> 5) & 1) << 8); }
constexpr int v_rd_off(int d0, int ks, int half) { return d0 * 512 + ks * 4096 + half * 2048; }
__device__ __forceinline__ int crow(int r, int hi) { return (r & 3) + 8 * (r >> 2) + 4 * hi; }
__device__ __forceinline__ unsigned cvtpk(float lo, float hi) { unsigned r; asm volatile("v_cvt_pk_bf16_f32 %0, %1, %2" : "=v"(r) : "v"(lo), "v"(hi)); return r; }
__device__ __forceinline__ bf16x8 load8(const bf16* p) { return *reinterpret_cast<const bf16x8*>(p); }
__device__ __forceinline__ void mask_tile(f32x16& p0, f32x16& p1, int dq, unsigned W) {
    const float NEG = -__builtin_inff();
#pragma unroll
    for (int r = 0; r < 16; ++r) {
        const int c = (r & 3) + 8 * (r >> 2);
        if ((unsigned)(dq - c) >= W) p0[r] = NEG;
        if ((unsigned)(dq - c - 32) >= W) p1[r] = NEG;
    }
}
__device__ __forceinline__ void partialSM(f32x16& p0, f32x16& p1, float& m_reg, float& mn, float& alpha) {
    float pmax = p0[0]; for (int r = 1; r < 16; ++r) pmax = fmaxf(pmax, p0[r]); for (int r = 0; r < 16; ++r) pmax = fmaxf(pmax, p1[r]);
    { auto rr = __builtin_amdgcn_permlane32_swap(__float_as_uint(pmax), __float_as_uint(pmax), false, false);
      pmax = fmaxf(__uint_as_float(rr[0]), __uint_as_float(rr[1])); }
    constexpr float C2 = 1.4426950408889634f * SCALE;
    if (__builtin_expect(__all((pmax - m_reg) * SCALE <= THR), 1)) { mn = m_reg; alpha = 1.f; }
    else { mn = fmaxf(m_reg, pmax); alpha = __builtin_amdgcn_exp2f((m_reg - mn) * C2); m_reg = mn; }
    const float mnL = -mn * C2;
    for (int r = 0; r < 16; ++r) p0[r] = fmaf(p0[r], C2, mnL); for (int r = 0; r < 16; ++r) p1[r] = fmaf(p1[r], C2, mnL);
    for (int r = 0; r < 16; ++r) p0[r] = __builtin_amdgcn_exp2f(p0[r]);
}
__device__ __forceinline__ void finishSM(f32x16& p0, f32x16& p1, float alpha, float& l_reg, bf16x8& pa0, bf16x8& pa1, bf16x8& pa2, bf16x8& pa3) {
    for (int r = 0; r < 16; ++r) p1[r] = __builtin_amdgcn_exp2f(p1[r]);
    float ps = 0; for (int r = 0; r < 16; ++r) ps += p0[r]; for (int r = 0; r < 16; ++r) ps += p1[r];
    { auto rr = __builtin_amdgcn_permlane32_swap(__float_as_uint(ps), __float_as_uint(ps), false, false);
      ps = __uint_as_float(rr[0]) + __uint_as_float(rr[1]); }
    l_reg = l_reg * alpha + ps;
#define PK4(P, B_, OUT) do { unsigned a0 = cvtpk(P[B_+0], P[B_+1]), a1 = cvtpk(P[B_+2], P[B_+3]);                          \
        unsigned b0 = cvtpk(P[B_+4], P[B_+5]), b1 = cvtpk(P[B_+6], P[B_+7]);                                             \
        auto r0 = __builtin_amdgcn_permlane32_swap(a0, b0, false, false); auto r1 = __builtin_amdgcn_permlane32_swap(a1, b1, false, false); \
        u32x4 w = {r0[0], r1[0], r0[1], r1[1]}; OUT = *reinterpret_cast<bf16x8*>(&w); } while (0)
    PK4(p0, 0, pa0); PK4(p0, 8, pa1); PK4(p1, 0, pa2); PK4(p1, 8, pa3);
#undef PK4
}
template <int KB>
__device__ __forceinline__ void qkt(f32x16& p0, f32x16& p1, const char* K_lds, int r32, int hi, const bf16x8* qr, const float* bp) {
    {
        const f32x4 a0 = *(const f32x4*)(bp), a1 = *(const f32x4*)(bp + 8), a2 = *(const f32x4*)(bp + 16), a3 = *(const f32x4*)(bp + 24);
        const f32x4 c0 = *(const f32x4*)(bp + 32), c1 = *(const f32x4*)(bp + 40), c2 = *(const f32x4*)(bp + 48), c3 = *(const f32x4*)(bp + 56);
#pragma unroll
        for (int i = 0; i < 4; ++i) { p0[i] = a0[i]; p0[4 + i] = a1[i]; p0[8 + i] = a2[i]; p0[12 + i] = a3[i]; p1[i] = c0[i]; p1[4 + i] = c1[i]; p1[8 + i] = c2[i]; p1[12 + i] = c3[i]; }
    }
    const char* kb[4];
#pragma unroll
    for (int dd = 0; dd < 4; ++dd) kb[dd] = K_lds + KB * SHM_K + KSWZ(r32, (dd * 16 + hi * 8) * 2);
#pragma unroll
    for (int d0 = 0; d0 < 8; ++d0) { const char* a = kb[d0 & 3] + (d0 >> 2) * 128;
        bf16x8 b0 = *reinterpret_cast<const bf16x8*>(a);
        bf16x8 b1 = *reinterpret_cast<const bf16x8*>(a + 32 * 256);
        p0 = __builtin_amdgcn_mfma_f32_32x32x16_bf16(b0, qr[d0], p0, 0, 0, 0);
        p1 = __builtin_amdgcn_mfma_f32_32x32x16_bf16(b1, qr[d0], p1, 0, 0, 0); }
}
template <int VB>
__device__ __forceinline__ void pv_tile(f32x16* o, int vb0, bf16x8 pa0, bf16x8 pa1, bf16x8 pa2, bf16x8 pa3) {
#define TRRD(dst, off) asm volatile("ds_read_b64_tr_b16 %0, %1 offset:%2" : "=&v"(dst) : "v"(vb0), "i"(off) : "memory")
#define PV_D0(d0) do { s16x4 l0, l1, l2, l3, h0, h1, h2, h3; constexpr int b_ = VB * SHM_V + v_rd_off(d0, 0, 0);   \
        TRRD(l0, b_); TRRD(h0, b_ + 2048); TRRD(l1, b_ + 4096); TRRD(h1, b_ + 6144); TRRD(l2, b_ + 8192); TRRD(h2, b_ + 10240); TRRD(l3, b_ + 12288); TRRD(h3, b_ + 14336); \
        asm volatile("s_waitcnt lgkmcnt(0)" ::: "memory"); SBAR();   \
        o[d0] = __builtin_amdgcn_mfma_f32_32x32x16_bf16(pa0, (bf16x8){l0[0], l0[1], l0[2], l0[3], h0[0], h0[1], h0[2], h0[3]}, o[d0], 0, 0, 0);   \
        o[d0] = __builtin_amdgcn_mfma_f32_32x32x16_bf16(pa1, (bf16x8){l1[0], l1[1], l1[2], l1[3], h1[0], h1[1], h1[2], h1[3]}, o[d0], 0, 0, 0);   \
        o[d0] = __builtin_amdgcn_mfma_f32_32x32x16_bf16(pa2, (bf16x8){l2[0], l2[1], l2[2], l2[3], h2[0], h2[1], h2[2], h2[3]}, o[d0], 0, 0, 0);   \
        o[d0] = __builtin_amdgcn_mfma_f32_32x32x16_bf16(pa3, (bf16x8){l3[0], l3[1], l3[2], l3[3], h3[0], h3[1], h3[2], h3[3]}, o[d0], 0, 0, 0); } while (0)
    PV_D0(0); PV_D0(1); PV_D0(2); PV_D0(3);
#undef PV_D0
#undef TRRD
}

struct BlockRef { const bf16* Q; const bf16* K; const bf16* V; bf16* O; int P0; int jlo; };
struct Seam { bf16x8 qr[8]; bf16x8 st_v0, st_v1, st_k0, st_k1; };
#define ROW(p, k0, rr) ((p) + (size_t)((k0) + (rr)) * D + sc)
#define VMW() asm volatile("s_waitcnt vmcnt(0)" ::: "memory")
#define VMWN(n) asm volatile("s_waitcnt vmcnt(%0)" :: "i"(n) : "memory")
#define SLOAD_H(Kp, Vp, k0) do { S.st_v0 = load8(ROW(Vp, k0, sr)); S.st_v1 = load8(ROW(Vp, k0, 32 + sr));              \
                         S.st_k0 = load8(ROW(Kp, k0, sr)); S.st_k1 = load8(ROW(Kp, k0, 32 + sr)); } while (0)
#define SWRITE_HK(bf) do { *(bf16x8*)(K_lds + (bf) * SHM_K + kws) = S.st_k0; *(bf16x8*)(K_lds + (bf) * SHM_K + kws + 32 * 256) = S.st_k1; } while (0)
#define SWRITE_HV(bf) do { *(bf16x8*)(V_lds + (bf) * SHM_V + vst0) = S.st_v0; *(bf16x8*)(V_lds + (bf) * SHM_V + vst1) = S.st_v1; } while (0)
#define SWRITE_H(bf) do { SWRITE_HV(bf); SWRITE_HK(bf); } while (0)
__device__ __forceinline__ void attn_prime(const BlockRef& cur, char* lds, Seam& S) {
    const int tid = threadIdx.x, wid = __builtin_amdgcn_readfirstlane(tid >> 6), lane = tid & 63, r32 = lane & 31, hi = lane >> 5;
    const int sr = tid >> 4, sc = (tid & 15) * 8, kws = KSWZ(sr, sc * 2); char* K_lds = lds + 2 * SHM_V;
    const int kb0 = cur.jlo * KVBLK;
#pragma unroll
    for (int d0 = 0; d0 < 8; ++d0) S.qr[d0] = load8(cur.Q + (size_t)(wid * QBLK + r32) * D + d0 * 16 + hi * 8);
    SLOAD_H(cur.K, cur.V, kb0); VMW(); SWRITE_HK(0);
    __syncthreads();
}
__device__ __forceinline__ void attn_block(const BlockRef& cur, const BlockRef& nxt, char* lds, Seam& S) {
    const int tid = threadIdx.x, wid = __builtin_amdgcn_readfirstlane(tid >> 6), lane = tid & 63, r32 = lane & 31, hi = lane >> 5;
    const int j_lo = cur.jlo;
    const int j_hi = (cur.P0 + QB - 1) / KVBLK + 1;
    const int NT = j_hi - j_lo;
    const int kbn = nxt.jlo * KVBLK;
    const int qlo = cur.P0 + wid * QBLK, qm = qlo + r32 - 4 * hi;
    char* V_lds = lds; char* K_lds = lds + 2 * SHM_V;
    float* ws = (float*)(lds + WS_OFF) + wid * 64; float* li_l = ws, * al_l = ws + 32;
    const float* bias_l = (const float*)(lds + BIAS_OFF) + 4 * hi;
    float m_reg = -1e30f, l_reg = 0; f32x16 o[4] = {};
    const int sr = tid >> 4, sc = (tid & 15) * 8, vst0 = v_st(sr, sc), vst1 = v_st(32 + sr, sc), kws = KSWZ(sr, sc * 2);
    const int vb0 = (int)(uintptr_t)V_lds + v_rd_base(lane);
    const bf16* Kh = cur.K; const bf16* Vh = cur.V;
#define RESC(a) do { if (__any((a) < 1.f)) { if (hi == 0) al_l[r32] = (a); asm volatile("s_waitcnt lgkmcnt(0)" ::: "memory");              \
                     for (int d_ = 0; d_ < 4; ++d_) for (int r = 0; r < 16; ++r) o[d_][r] *= al_l[crow(r, hi)]; } } while (0)
#define KBASE(t) ((j_lo + (t)) * KVBLK)
#define MASKT(P0_, P1_, t) do { const int kb_ = KBASE(t); if (kb_ + KVBLK - 1 > qlo) mask_tile(P0_, P1_, qm - kb_, WBIG); } while (0)
    constexpr int NQL = 8;
#define SEAM_K0() do { VMWN(NQL); SWRITE_HK(0); SBAR(); } while (0)
    f32x16 pA0, pA1, pB0, pB1; float mnA, mnB, alA, alB; bf16x8 pa0, pa1, pa2, pa3;
    SWRITE_HV(0); SBAR();
    if (NT > 1) { SLOAD_H(Kh, Vh, KBASE(1)); }
    SBAR(); qkt<0>(pA0, pA1, K_lds, r32, hi, S.qr, bias_l + KBASE(0));
    MASKT(pA0, pA1, 0); partialSM(pA0, pA1, m_reg, mnA, alA);
    if (NT > 1) { VMW(); SWRITE_H(1); }
    __syncthreads();
#define HALF_STEP(PX0, PX1, mnX, alX, PY0, PY1, alY, t, KB, VB, SB) do {                                                      \
        SBAR(); qkt<KB>(PX0, PX1, K_lds, r32, hi, S.qr, bias_l + KBASE(t));                                                   \
        finishSM(PY0, PY1, alY, l_reg, pa0, pa1, pa2, pa3); SBAR();                                                           \
        if ((t) + 1 < NT) { SLOAD_H(Kh, Vh, KBASE((t) + 1)); SBAR(); }                                                        \
        pv_tile<VB>(o, vb0, pa0, pa1, pa2, pa3); MASKT(PX0, PX1, (t)); partialSM(PX0, PX1, m_reg, mnX, alX);                  \
        __syncthreads();                                                                                                      \
        if ((t) + 1 < NT) { VMW(); SWRITE_H(SB); }                                                                            \
        RESC(alX); __syncthreads(); } while (0)
    for (int t = 1; t + 1 < NT; t += 2) {
        HALF_STEP(pB0, pB1, mnB, alB, pA0, pA1, alA, t, 1, 0, 0);
        HALF_STEP(pA0, pA1, mnA, alA, pB0, pB1, alB, t + 1, 0, 1, 1);
    }
    const bool even = (NT & 1) == 0;
    if (even) { SBAR(); qkt<1>(pB0, pB1, K_lds, r32, hi, S.qr, bias_l + KBASE(NT - 1)); SBAR(); }
    SLOAD_H(nxt.K, nxt.V, kbn); SBAR();
    int tz = threadIdx.x; asm volatile("" : "+v"(tz));
    const int r32b = tz & 31, hib = (tz >> 5) & 1;
    { const bf16* qn = nxt.Q + (unsigned)((wid * QBLK + r32b) * D + hib * 8);
#pragma unroll
    for (int d0 = 0; d0 < 8; ++d0) S.qr[d0] = load8(qn + d0 * 16); }
    SBAR();
    finishSM(pA0, pA1, alA, l_reg, pa0, pa1, pa2, pa3); SBAR();
    pv_tile<0>(o, vb0, pa0, pa1, pa2, pa3);
    if (even) { MASKT(pB0, pB1, NT - 1); partialSM(pB0, pB1, m_reg, mnB, alB); __syncthreads(); RESC(alB);
        finishSM(pB0, pB1, alB, l_reg, pa0, pa1, pa2, pa3); SBAR(); pv_tile<1>(o, vb0, pa0, pa1, pa2, pa3); }
    SBAR(); SEAM_K0();
    if (hi == 0) li_l[r32] = l_reg; asm volatile("s_waitcnt lgkmcnt(0)" ::: "memory");
    float rli[16];
#pragma unroll
    for (int r = 0; r < 16; ++r) rli[r] = __builtin_amdgcn_rcpf(li_l[crow(r, hi)]);
    bf16* Ow = cur.O + (size_t)(wid * QBLK) * OP + (unsigned)(4 * hib * OP + r32b);
#pragma unroll
    for (int r = 0; r < 16; ++r) { const int orow0 = (r & 3) + 8 * (r >> 2);
#pragma unroll
        for (int d0 = 0; d0 < 4; ++d0) { const float v = o[d0][r] * rli[r];
            const float vn = __shfl_xor(v, 1);
            if ((r32b & 1) == 0) *(unsigned*)(Ow + orow0 * OP + d0 * 32) = cvtpk(v, vn); } }
    __syncthreads();
#undef RESC
#undef KBASE
#undef MASKT
#undef SEAM_K0
#undef HALF_STEP
}
#undef ROW
#undef VMW
#undef VMWN
#undef SLOAD_H
#undef SWRITE_HK
#undef SWRITE_HV
#undef SWRITE_H
#undef KSWZ
#undef SBAR
}

constexpr int NWAVES = 8;
constexpr int N_LAUNCHES = MK_N_LAUNCHES;
constexpr int N_PHASES = 13;
constexpr int DM = 4096, SEQ = 8192, NMETA = 16, DFF = 11008, NGU = 2 * DFF, INCOLS = 12304, NQKV = 12288, NIN = 12544, HD = 128;
constexpr int PADF = 240, XR0 = 256, MP = 8448;
constexpr int NCHUNK = 96;
constexpr float RMS_EPS = 1e-6f, SUBLN_EPS = 1e-5f, LAMBDA_INIT = 0.2f;
constexpr float INV_SCALE = 11.313708498984761f;

constexpr size_t MiB = 1u << 20;
constexpr size_t WS_CTL = 0, CTL_ZERO_BYTES = 1 * MiB;
constexpr size_t SZ_WGU = (size_t)NGU * DM * 2, SZ_WD = (size_t)DM * DFF * 2, SZ_WIN = (size_t)NIN * DM * 2, SZ_WOUT = (size_t)DM * DM * 2;
constexpr size_t WS_W1GU = 1 * MiB, WS_W1D = WS_W1GU + SZ_WGU, WS_WIN = WS_W1D + SZ_WD, WS_WOUT = WS_WIN + SZ_WIN, WS_W2GU = WS_WOUT + SZ_WOUT, WS_W2D = WS_W2GU + SZ_WGU;
constexpr size_t WS_H = WS_W2D + SZ_WD;
constexpr size_t WS_XN = WS_H + (size_t)MP * DM * 4;
constexpr size_t WS_BIG = WS_XN + (size_t)MP * DM * 2;
constexpr size_t SZ_BIG = (size_t)NCHUNK * MP * HD * 2;
constexpr size_t WS_O = WS_BIG + SZ_BIG;
constexpr size_t WS_O1 = WS_O + (size_t)MP * DM * 2;
constexpr size_t WS_LOGIT = WS_O1 + (size_t)MP * DM * 2;
constexpr size_t WS_BIAS = WS_LOGIT + (size_t)MP * 16 * 4;
constexpr size_t WS_END = WS_BIAS + (size_t)24 * MP * 4;
static_assert((size_t)MP * DFF * 2 <= SZ_BIG, "FFN hidden fits the shared region");
static_assert(WS_W1GU % 256 == 0 && WS_W1D % 256 == 0 && WS_WIN % 256 == 0 && WS_H % 256 == 0 && WS_XN % 256 == 0 && WS_BIG % 256 == 0 && WS_O % 256 == 0 && WS_LOGIT % 256 == 0 && WS_BIAS % 256 == 0, "alignment");
constexpr int CW_BAR = 4096;
constexpr int CW_QUEUE = 8192;
constexpr int CW_T1Q = 9216, CW_CONVQ = 9280, CW_CONVQ2 = 9344;
constexpr int CW_NORM = 12288;

constexpr int RING_OFF = 0, RING_BYTES = 135168;
constexpr int LDSCTL_OFF = RING_BYTES, MISC_OFF = LDSCTL_OFF + 320;
constexpr int LDS_BYTES = 147456;
static_assert(MISC_OFF + 128 <= LDS_BYTES && att::ATT_LDS_BYTES <= RING_BYTES, "LDS map");

#define GAS __attribute__((address_space(1)))
#define LAS __attribute__((address_space(3)))
typedef unsigned short bf16;
typedef unsigned v4u __attribute__((ext_vector_type(4)));
typedef unsigned v2u __attribute__((ext_vector_type(2)));
typedef float f32x4 __attribute__((ext_vector_type(4)));
typedef GAS unsigned gu32;
#define RLX_AGENT __ATOMIC_RELAXED, __HIP_MEMORY_SCOPE_AGENT
#define LDS_WAIT() asm volatile("s_waitcnt lgkmcnt(0)" ::: "memory")
#define VM_WAIT() asm volatile("s_waitcnt vmcnt(0)" ::: "memory")
__device__ __forceinline__ unsigned f2bf(float f) { unsigned u = __builtin_bit_cast(unsigned, f); return (u + 0x7fffu + ((u >> 16) & 1u)) >> 16; }
__device__ __forceinline__ unsigned pk2(float lo, float hi) { return f2bf(lo) | (f2bf(hi) << 16); }
__device__ __forceinline__ float bf_lo(unsigned w) { return __builtin_bit_cast(float, w << 16); }
__device__ __forceinline__ float bf_hi(unsigned w) { return __builtin_bit_cast(float, w & 0xffff0000u); }
#define XB_TMO      128
#define XB_XCNT(j)  (256  + 64 * (j))
#define XB_XSUB(j)  (1280 + 64 * (j))
#define XB_XGEN(j)  (2304 + 64 * (j))
#define XB_TOP      3328
#define XB_TOPGEN   3392
#define XCD_BAR_WORDS 3456
#define XB_SPIN_CAP (1u << 18)

__device__ __forceinline__ unsigned xb_ld(unsigned* p)              { return __hip_atomic_load(p, __ATOMIC_RELAXED, __HIP_MEMORY_SCOPE_AGENT); }
__device__ __forceinline__ unsigned xb_add(unsigned* p, unsigned v) { return __hip_atomic_fetch_add(p, v, __ATOMIC_RELAXED, __HIP_MEMORY_SCOPE_AGENT); }
__device__ __forceinline__ unsigned xb_xcc_id() { return (unsigned)__builtin_amdgcn_s_getreg((3 << 11) | 20) & 0xFu; }
#define XB_SPIN(cond, bar) do { unsigned _sp = 0; while (cond) { __builtin_amdgcn_s_sleep(1); \
    if ((++_sp & 255u) == 0u) { if (xb_ld(&(bar)[XB_TMO])) break; if (_sp > XB_SPIN_CAP) { atomicAdd(&(bar)[XB_TMO], 1u); break; } } } } while (0)

struct XcdBarrier {
    unsigned* bar; unsigned x;
    volatile LAS unsigned* st;
};

__device__ __forceinline__ XcdBarrier xcd_barrier_post(unsigned* bar, volatile LAS unsigned* st) {
    XcdBarrier b; b.bar = bar; b.x = xb_xcc_id(); b.st = st;
    if (threadIdx.x == 0) (void)xb_add(&bar[XB_XCNT(b.x)], 1u);
    return b;
}
__device__ __forceinline__ void xcd_barrier_complete(unsigned* bar, unsigned x, unsigned& nloc, unsigned& nx) {
    const unsigned G = gridDim.x * gridDim.y * gridDim.z;
    unsigned sum, cnt, mine, sp = 0u;
    for (;;) {
        sum = 0u; cnt = 0u; mine = 0u;
#pragma unroll
        for (unsigned j = 0; j < 16; ++j) { const unsigned c = xb_ld(&bar[XB_XCNT(j)]); sum += c; cnt += (c > 0u) ? 1u : 0u; mine = (j == x) ? c : mine; }
        if (sum == G) break;
        __builtin_amdgcn_s_sleep(1);
        if ((++sp & 255u) == 0u) { if (xb_ld(&bar[XB_TMO])) break; if (sp > XB_SPIN_CAP) { atomicAdd(&bar[XB_TMO], 1u); break; } }
    }
    nloc = mine > 0u ? mine : 1u; nx = cnt > 0u ? cnt : 1u;
}

__device__ __forceinline__ void xcd_barrier(const XcdBarrier& b) {
    asm volatile("s_waitcnt vmcnt(0)" ::: "memory");
    __syncthreads();
    if (threadIdx.x == 0) {
        unsigned* bar = b.bar;
        __builtin_amdgcn_s_waitcnt(0);
        unsigned nloc = b.st[0], nx = b.st[1];
        if (nloc == 0u) { xcd_barrier_complete(bar, b.x, nloc, nx); b.st[0] = nloc; b.st[1] = nx; }
        const unsigned old = xb_add(&bar[XB_XSUB(b.x)], 1u);
        const unsigned gen = old / nloc;
        if (old + 1u == (gen + 1u) * nloc) {
            __builtin_amdgcn_fence(__ATOMIC_RELEASE, "agent");
            asm volatile("s_waitcnt vmcnt(0)" ::: "memory");
            const unsigned og = xb_add(&bar[XB_TOP], 1u);
            const unsigned tg = og / nx;
            if (og + 1u == (tg + 1u) * nx) xb_add(&bar[XB_TOPGEN], 1u);
            else XB_SPIN(xb_ld(&bar[XB_TOPGEN]) == tg, bar);
            __builtin_amdgcn_fence(__ATOMIC_ACQUIRE, "agent");
            xb_add(&bar[XB_XGEN(b.x)], 1u);
            asm volatile("s_waitcnt vmcnt(0)" ::: "memory");
        } else {
            XB_SPIN(xb_ld(&bar[XB_XGEN(b.x)]) == gen, bar);
            __builtin_amdgcn_fence(__ATOMIC_ACQUIRE, "agent");
            asm volatile("s_waitcnt vmcnt(0)" ::: "memory");
        }
    }
    __syncthreads();
}


struct Frame {
    LAS unsigned char* lds;
    volatile LAS unsigned* MISC;
    gu32* ctl;
    int tid, lane, wave;
    int vcu, G;
};
__device__ __forceinline__ float wave_sum(float v) {
#pragma unroll
    for (int o = 1; o < 64; o <<= 1) v += __shfl_xor(v, o);
    return v;
}
struct TItem { const float* src; bf16* dst; const float* gain; int ldw, K, ncol, pad; };
__device__ __forceinline__ void t_load(f32x4 (&v)[16], const TItem& t, int lane) {
    const int q = lane & 15, g = lane >> 4; const bool ok = 4 * q < t.ncol;
    const float* p = t.src + (size_t)g * t.ldw + 4 * q;
#pragma unroll
    for (int i = 0; i < 16; ++i) v[i] = ok ? __builtin_nontemporal_load((const GAS f32x4*)(p + (size_t)(4 * i) * t.ldw)) : (f32x4){0.f, 0.f, 0.f, 0.f};
}
__device__ __forceinline__ void t_store(const f32x4 (&v)[16], const TItem& t, LAS float* scr, int lane) {
    const int q = lane & 15, g = lane >> 4;
    LAS float* w = scr + g * 65 + 4 * q;
#pragma unroll
    for (int i = 0; i < 16; ++i) { w[(4 * i) * 65 + 0] = v[i].x; w[(4 * i) * 65 + 1] = v[i].y; w[(4 * i) * 65 + 2] = v[i].z; w[(4 * i) * 65 + 3] = v[i].w; }
    LDS_WAIT(); asm volatile("" ::: "memory");
    const int c = lane & 7, nn = lane >> 3;
    const LAS float* s = scr + (8 * c) * 65 + nn;
    bf16* d = t.dst + (size_t)nn * t.K + 8 * c;
    f32x4 ga = {1.f, 1.f, 1.f, 1.f}, gb = {1.f, 1.f, 1.f, 1.f};
    if (t.gain) { ga = *(const GAS f32x4*)(t.gain + 8 * c); gb = *(const GAS f32x4*)(t.gain + 8 * c + 4); }
#pragma unroll
    for (int j = 0; j < 8; ++j) { v4u o;
        o.x = pg8::cvt_pk_bf16(s[8 * j + 0 * 65] * ga.x, s[8 * j + 1 * 65] * ga.y); o.y = pg8::cvt_pk_bf16(s[8 * j + 2 * 65] * ga.z, s[8 * j + 3 * 65] * ga.w);
        o.z = pg8::cvt_pk_bf16(s[8 * j + 4 * 65] * gb.x, s[8 * j + 5 * 65] * gb.y); o.w = pg8::cvt_pk_bf16(s[8 * j + 6 * 65] * gb.z, s[8 * j + 7 * 65] * gb.w);
        __builtin_nontemporal_store(o, (GAS v4u*)(d + (size_t)(8 * j) * t.K)); }
    LDS_WAIT(); asm volatile("" ::: "memory");
}
__device__ __forceinline__ TItem t_item(const float* W, int ldw, int K, int nblk, int ncols, bf16* WT, int blk, int off, int r, const float* gain) {
    const int kb = r / nblk, nb = r - kb * nblk, n0 = 64 * nb;
    TItem t; t.src = W + (size_t)(64 * kb) * ldw + n0; t.dst = WT + (size_t)((n0 >> 7) * blk + off + (n0 & 127)) * K + 64 * kb; t.ldw = ldw; t.K = K;
    t.ncol = (ncols - n0) < 64 ? (ncols - n0) : 64; t.pad = 0; t.gain = gain ? gain + 64 * kb : nullptr; return t;
}
__device__ __forceinline__ void raw_row_bf16(const float* xrow, bf16* orow, unsigned long long* ss, int lane) {
    const GAS f32x4* xr = (const GAS f32x4*)xrow + lane;
    f32x4 v[16]; float s = 0.f;
#pragma unroll
    for (int j = 0; j < 16; ++j) { v[j] = xr[64 * j]; s += (v[j].x * v[j].x + v[j].y * v[j].y) + (v[j].z * v[j].z + v[j].w * v[j].w); }
    s = wave_sum(s);
    GAS v2u* o8 = (GAS v2u*)orow + lane;
#pragma unroll
    for (int j = 0; j < 16; ++j) { v2u w; w.x = pg8::cvt_pk_bf16(v[j].x, v[j].y); w.y = pg8::cvt_pk_bf16(v[j].z, v[j].w); o8[64 * j] = w; }
    if (lane == 0) *ss = (unsigned long long)(s * 16777216.0f);
}
typedef short bf16x8_t __attribute__((ext_vector_type(8)));
__device__ __forceinline__ f32x4 thin16(const bf16* a, const bf16* b, int nsteps) {
    f32x4 acc = {0.f, 0.f, 0.f, 0.f};
    int s = 0;
    for (; s + 16 <= nsteps; s += 16) {
        bf16x8_t av[16], bv[16];
#pragma unroll
        for (int u = 0; u < 16; ++u) { av[u] = *(const GAS bf16x8_t*)(a + (s + u) * 32); bv[u] = *(const GAS bf16x8_t*)(b + (s + u) * 32); }
#pragma unroll
        for (int u = 0; u < 16; ++u) acc = __builtin_amdgcn_mfma_f32_16x16x32_bf16(av[u], bv[u], acc, 0, 0, 0);
    }
    if (s < nsteps) {
        bf16x8_t av[15], bv[15];
#pragma unroll
        for (int u = 0; u < 15; ++u) if (s + u < nsteps) { av[u] = *(const GAS bf16x8_t*)(a + (s + u) * 32); bv[u] = *(const GAS bf16x8_t*)(b + (s + u) * 32); }
#pragma unroll
        for (int u = 0; u < 15; ++u) if (s + u < nsteps) acc = __builtin_amdgcn_mfma_f32_16x16x32_bf16(av[u], bv[u], acc, 0, 0, 0);
    }
    return acc;
}
__device__ __forceinline__ void thin16x2(const bf16* a, const bf16* b0, const bf16* b1, int nsteps, f32x4& acc0, f32x4& acc1) {
    acc0 = (f32x4){0.f, 0.f, 0.f, 0.f}; acc1 = (f32x4){0.f, 0.f, 0.f, 0.f};
    for (int s = 0; s + 8 <= nsteps; s += 8) {
        bf16x8_t av[8], bv[8], cv[8];
#pragma unroll
        for (int u = 0; u < 8; ++u) { av[u] = *(const GAS bf16x8_t*)(a + (s + u) * 32); bv[u] = *(const GAS bf16x8_t*)(b0 + (s + u) * 32); cv[u] = *(const GAS bf16x8_t*)(b1 + (s + u) * 32); }
#pragma unroll
        for (int u = 0; u < 8; ++u) { acc0 = __builtin_amdgcn_mfma_f32_16x16x32_bf16(av[u], bv[u], acc0, 0, 0, 0); acc1 = __builtin_amdgcn_mfma_f32_16x16x32_bf16(av[u], cv[u], acc1, 0, 0, 0); }
    }
}
__device__ __forceinline__ float thin_reduce(LAS float* red, f32x4 acc, int tid, int lane, int wave) {
    *(LAS f32x4*)(red + wave * 256 + lane * 4) = acc;
    __syncthreads();
    float s = 0.f;
    if (tid < 256) {
#pragma unroll
        for (int w = 0; w < 8; ++w) s += red[w * 256 + tid];
    }
    __syncthreads();
    return s;
}
__device__ __forceinline__ int hidden_tid() { int t = threadIdx.x; asm volatile("" : "+v"(t)); return t; }
struct Args { const float* in[20]; float* out; unsigned char* ws; int ph_lo, ph_hi; };

__global__ void __launch_bounds__(NWAVES * 64, 2) hymba_fwd(Args args) {
    extern __shared__ __attribute__((aligned(16))) unsigned char lds[];
    Frame F;
    F.lds = (LAS unsigned char*)lds;
    F.MISC = (volatile LAS unsigned*)(F.lds + MISC_OFF);
    F.tid = threadIdx.x; F.lane = F.tid & 63; F.wave = __builtin_amdgcn_readfirstlane(F.tid >> 6);
    F.G = gridDim.x; { const int bx = blockIdx.x; F.vcu = (F.G % 8 == 0) ? (bx % 8) * (F.G / 8) + bx / 8 : bx; }
    unsigned char* ws = args.ws;
    F.ctl = (gu32*)(ws + WS_CTL);
    const float* x = args.in[0]; const float* meta = args.in[1];
    bf16* W1GU = (bf16*)(ws + WS_W1GU); bf16* W1D = (bf16*)(ws + WS_W1D); bf16* WIN = (bf16*)(ws + WS_WIN); bf16* WOUT = (bf16*)(ws + WS_WOUT);
    bf16* W2GU = (bf16*)(ws + WS_W2GU); bf16* W2D = (bf16*)(ws + WS_W2D);
    float* H = (float*)(ws + WS_H); bf16* XN = (bf16*)(ws + WS_XN); bf16* ACT = (bf16*)(ws + WS_BIG); bf16* PROJ = (bf16*)(ws + WS_BIG);
    bf16* OB = (bf16*)(ws + WS_O); bf16* O1B = (bf16*)(ws + WS_O1); float* LOGIT = (float*)(ws + WS_LOGIT); float* BIAS = (float*)(ws + WS_BIAS);
    unsigned long long* SS0 = (unsigned long long*)(ws + WS_CTL + 256 * 1024); unsigned long long* SS1 = (unsigned long long*)(ws + WS_CTL + 384 * 1024); unsigned long long* SS2 = (unsigned long long*)(ws + WS_CTL + 512 * 1024);
    for (int u = F.tid; u < (LDS_BYTES - LDSCTL_OFF) / 4; u += NWAVES * 64) ((LAS unsigned*)(F.lds + LDSCTL_OFF))[u] = 0u;
    __syncthreads();
    XcdBarrier bar; bar.bar = (unsigned*)(F.ctl + CW_BAR); bar.x = 0; bar.st = nullptr;
    if (N_LAUNCHES == 1) bar = xcd_barrier_post((unsigned*)(F.ctl + CW_BAR), F.MISC + 8);
#define GRID_BAR() do { if (N_LAUNCHES == 1) xcd_barrier(bar); } while (0)
    const int lo = args.ph_lo, hi = args.ph_hi;
#define IN(k) (lo <= (k) && (k) < hi)
#define BOTH(k) (IN(k) && IN((k) + 1))
    const int gw = F.vcu * NWAVES + F.wave, NGW = F.G * NWAVES;

    constexpr int I_GU = (DM / 64) * (DFF / 64), I_D = (DFF / 64) * (DM / 64), I_IN = (DM / 64) * 193, I_OUT = (DM / 64) * (DM / 64);
    constexpr int NITEMS = 4 * I_GU + 2 * I_D + I_IN + I_OUT, N0 = 2 * I_GU;
#define T_DECODE(T_, it_) do { int r_ = (it_);                                                                                     \
            if (r_ < I_GU) { T_ = t_item(args.in[3], DFF, DM, DFF / 64, DFF, W1GU, 256, 0, r_, args.in[2]); break; } r_ -= I_GU;                 \
            if (r_ < I_GU) { T_ = t_item(args.in[4], DFF, DM, DFF / 64, DFF, W1GU, 256, 128, r_, args.in[2]); break; } r_ -= I_GU;               \
            if (r_ < I_D) { T_ = t_item(args.in[5], DM, DFF, DM / 64, DM, W1D, 128, 0, r_, nullptr); break; } r_ -= I_D;                      \
            if (r_ < I_IN) { T_ = t_item(args.in[7], INCOLS, DM, 193, INCOLS, WIN, 128, 0, r_, args.in[6]); break; } r_ -= I_IN;                 \
            if (r_ < I_OUT) { T_ = t_item(args.in[14], DM, DM, DM / 64, DM, WOUT, 128, 0, r_, nullptr); break; } r_ -= I_OUT;                 \
            if (r_ < I_GU) { T_ = t_item(args.in[16], DFF, DM, DFF / 64, DFF, W2GU, 256, 0, r_, args.in[15]); break; } r_ -= I_GU;                \
            if (r_ < I_GU) { T_ = t_item(args.in[17], DFF, DM, DFF / 64, DFF, W2GU, 256, 128, r_, args.in[15]); break; } r_ -= I_GU;              \
            T_ = t_item(args.in[18], DM, DFF, DM / 64, DM, W2D, 128, 0, r_, nullptr); } while (0)
#define Q_POP(dst_, QW_) do { int v_ = 0; if (lane == 0) v_ = (int)__hip_atomic_fetch_add((unsigned*)(F.ctl + (QW_)), 8u, RLX_AGENT); dst_ = __builtin_amdgcn_readfirstlane(v_); } while (0)
#define Q_NEXT(dst_, QW_) do { if (q_it >= q_end) { if (q_next < NQ) { q_it = q_next; q_end = (q_next + CHK) < NQ ? (q_next + CHK) : NQ; Q_POP(q_next, QW_); } } \
                          if (q_it < q_end) { dst_ = q_it; ++q_it; } else dst_ = -1; } while (0)
#define CONV_STREAM(QW_, FIRST_, COUNT_) do { \
        { \
            LAS float* scr = (LAS float*)(F.lds + RING_OFF + F.wave * 16640); \
            const int NQ = (COUNT_); constexpr int CHK = 8; \
            int q_it = 0, q_end = 0, q_next = 0; \
            Q_POP(q_next, QW_); \
            f32x4 va[16], vb[16], vc[16]; TItem ta, tb, tc; int i0, i1, i2; \
            Q_NEXT(i0, QW_); if (i0 >= 0) { T_DECODE(ta, (FIRST_) + i0); t_load(va, ta, lane); } \
            Q_NEXT(i1, QW_); if (i1 >= 0) { T_DECODE(tb, (FIRST_) + i1); t_load(vb, tb, lane); } \
            for (;;) { \
                if (i0 < 0) break; \
                Q_NEXT(i2, QW_); if (i2 >= 0) { T_DECODE(tc, (FIRST_) + i2); t_load(vc, tc, lane); } \
                t_store(va, ta, scr, lane); \
                if (i1 < 0) break; \
                Q_NEXT(i0, QW_); if (i0 >= 0) { T_DECODE(ta, (FIRST_) + i0); t_load(va, ta, lane); } \
                t_store(vb, tb, scr, lane); \
                if (i2 < 0) break; \
                Q_NEXT(i1, QW_); if (i1 >= 0) { T_DECODE(tb, (FIRST_) + i1); t_load(vb, tb, lane); } \
                t_store(vc, tc, scr, lane); \
            } \
        } \
    } while (0)
    if (IN(0)) {
        const int tid = hidden_tid(), lane = tid & 63; (void)tid; (void)lane;
        LAS float* scr = (LAS float*)(F.lds + RING_OFF + F.wave * 16640);
        {
            f32x4 va[16], vb[16]; TItem ta, tb;
            int it = gw;
            if (it < N0) {
                T_DECODE(ta, it); t_load(va, ta, lane);
                for (;;) {
                    const int itn = it + NGW;
                    if (itn < N0) { T_DECODE(tb, itn); t_load(vb, tb, lane); }
                    t_store(va, ta, scr, lane);
                    if (itn >= N0) break;
                    const int it2 = itn + NGW;
                    if (it2 < N0) { T_DECODE(ta, it2); t_load(va, ta, lane); }
                    t_store(vb, tb, scr, lane);
                    if (it2 >= N0) break;
                    it = it2;
                }
            }
        }
        { GAS v4u* z = (GAS v4u*)(WIN + (size_t)12352 * DM); const size_t n16 = (size_t)(NIN - 12352) * DM * 2 / 16;
          for (size_t i = (size_t)blockIdx.x * 512 + tid; i < n16; i += (size_t)F.G * 512) z[i] = (v4u){0u, 0u, 0u, 0u}; }
        for (int m = PADF + gw; m < MP; m += NGW)
            raw_row_bf16(m < XR0 ? meta + (size_t)(m - PADF) * DM : x + (size_t)(m - XR0) * DM, XN + (size_t)m * DM, SS0 + m, lane);
        if (BOTH(0)) GRID_BAR();
    }
    if (IN(1)) {
        constexpr int GG = 232;
        const int tid = hidden_tid(), lane = tid & 63;
        volatile LAS int* MQ = (volatile LAS int*)(F.lds + MISC_OFF) + 16;
        if ((int)blockIdx.x < GG) {
            pg8::Gemm g{XN + (size_t)XR0 * DM, W1GU, SEQ, NGU, DM}; pg8::StaticOrder S; S.init(SEQ, NGU, GG, (int)blockIdx.x);
            pg8::EpiSwiGLU E{ACT, DFF, XR0, SS0};
            pg8::gemm_phase<pg8::EpiSwiGLU, pg8::StaticOrder, true, true>(F.lds + RING_OFF, g, S, E);
        }
        {
            LAS float* red = (LAS float*)(F.lds + RING_OFF);
            const bf16* a = XN + (size_t)(PADF + (lane & 15)) * DM + 512 * F.wave + 8 * (lane >> 4);
            for (;;) {
                if (tid == 0) MQ[4] = (int)__hip_atomic_fetch_add((unsigned*)(F.ctl + CW_T1Q), 4u, RLX_AGENT);
                __syncthreads();
                const int cb0 = MQ[4];
                if (cb0 >= DFF / 16) break;
                f32x4 ag[4], au[4];
#pragma unroll
                for (int i = 0; i < 4; ++i) { const int c0 = 16 * (cb0 + i); const bf16* b0 = W1GU + (size_t)((c0 >> 7) * 256 + (c0 & 127) + (lane & 15)) * DM + 512 * F.wave + 8 * (lane >> 4);
                    thin16x2(a, b0, b0 + (size_t)128 * DM, 16, ag[i], au[i]); }
#pragma unroll
                for (int i = 0; i < 4; ++i) { *(LAS f32x4*)(red + ((2 * i) * 8 + F.wave) * 256 + lane * 4) = ag[i]; *(LAS f32x4*)(red + ((2 * i + 1) * 8 + F.wave) * 256 + lane * 4) = au[i]; }
                __syncthreads();
                if (tid < 256) { const int l = tid >> 2, tok = 4 * (l >> 4) + (tid & 3), col = l & 15; const float rs = pg8::rstd_of(SS0, PADF + tok, RMS_EPS);
#pragma unroll
                    for (int i = 0; i < 4; ++i) { float gs = 0.f, us = 0.f;
#pragma unroll
                        for (int w = 0; w < 8; ++w) { gs += red[((2 * i) * 8 + w) * 256 + tid]; us += red[((2 * i + 1) * 8 + w) * 256 + tid]; }
                        ACT[(size_t)(PADF + tok) * DFF + 16 * (cb0 + i) + col] = (bf16)f2bf(pg8::silu_mul(gs * rs, us * rs)); } }
                __syncthreads();
            }
            __syncthreads();
        }
        CONV_STREAM(CW_CONVQ, N0, NITEMS - N0 - I_D);
        if (BOTH(1)) GRID_BAR();
    }
    if (IN(2)) {
        pg8::Gemm g{ACT + (size_t)XR0 * DFF, W1D, SEQ, DM, DFF}; pg8::StaticOrder S; S.init(SEQ, DM, F.G, (int)blockIdx.x);
        pg8::EpiResid<true> E{x, XR0, H, DM, 0.5f, XR0, XN, SS1};
        pg8::gemm_phase<pg8::EpiResid<true>, pg8::StaticOrder, true, true>(F.lds + RING_OFF, g, S, E);
        {
            const int tid = hidden_tid(), lane = tid & 63;
            LAS float* red = (LAS float*)(F.lds + RING_OFF);
            const bf16* a = ACT + (size_t)(PADF + (lane & 15)) * DFF + 1376 * F.wave + 8 * (lane >> 4);
            for (int cb = blockIdx.x; cb < DM / 16; cb += F.G) {
                const int c0 = 16 * cb; const bf16* b = W1D + (size_t)(c0 + (lane & 15)) * DFF + 1376 * F.wave + 8 * (lane >> 4);
                const float sum = thin_reduce(red, thin16(a, b, 43), tid, lane, F.wave);
                if (tid < 256) { const int l = tid >> 2, tok = 4 * (l >> 4) + (tid & 3), col = l & 15; const float hv = meta[(size_t)tok * DM + c0 + col] + 0.5f * sum;
                    H[(size_t)(PADF + tok) * DM + c0 + col] = hv; XN[(size_t)(PADF + tok) * DM + c0 + col] = (bf16)f2bf(hv);
                    float sq = hv * hv; sq += __shfl_xor(sq, 4); sq += __shfl_xor(sq, 8); sq += __shfl_xor(sq, 16); sq += __shfl_xor(sq, 32);
                    if (col == 0) __hip_atomic_fetch_add(SS1 + PADF + tok, (unsigned long long)(sq * 16777216.0f), RLX_AGENT); }
            }
        }
        if (BOTH(2)) GRID_BAR();
    }
    if (IN(4)) {
        pg8::Gemm g{XN + (size_t)XR0 * DM, WIN, SEQ, NQKV, DM}; pg8::StaticOrder S; S.init(SEQ, NQKV, F.G, (int)blockIdx.x);
        pg8::EpiProj E{PROJ, (size_t)MP * HD, LOGIT, XR0, SS1};
        pg8::gemm_phase<pg8::EpiProj, pg8::StaticOrder, true, true>(F.lds + RING_OFF, g, S, E);
        {
            const int tid = hidden_tid(), lane = tid & 63;
            LAS float* red = (LAS float*)(F.lds + RING_OFF);
            const size_t CH = (size_t)MP * HD;
            constexpr int NTASK = 513 + SEQ / 16;
            f32x4 accs[5];
#pragma unroll
            for (int i = 0; i < 5; ++i) { const int t = (int)blockIdx.x + i * F.G; accs[i] = (f32x4){0.f, 0.f, 0.f, 0.f};
                if (t < NTASK) { int arow, brow; if (t < 512) { const int kc = t >> 3, chunk = kc < 32 ? 16 + kc : 32 + kc; arow = PADF; brow = chunk * 128 + (t & 7) * 16; }
                    else if (t == 512) { arow = PADF; brow = NQKV; } else { arow = XR0 + 16 * (t - 513); brow = NQKV; }
                    accs[i] = thin16(XN + (size_t)(arow + (lane & 15)) * DM + 512 * F.wave + 8 * (lane >> 4), WIN + (size_t)(brow + (lane & 15)) * DM + 512 * F.wave + 8 * (lane >> 4), 16); } }
#pragma unroll
            for (int i = 0; i < 5; ++i) *(LAS f32x4*)(red + (i * 8 + F.wave) * 256 + lane * 4) = accs[i];
            __syncthreads();
            if (tid < 256) {
#pragma unroll
                for (int i = 0; i < 5; ++i) { const int t = (int)blockIdx.x + i * F.G;
                    if (t < NTASK) { float sum = 0.f;
#pragma unroll
                        for (int w = 0; w < 8; ++w) sum += red[(i * 8 + w) * 256 + tid];
                        int arow, brow; if (t < 512) { const int kc = t >> 3, chunk = kc < 32 ? 16 + kc : 32 + kc; arow = PADF; brow = chunk * 128 + (t & 7) * 16; }
                        else if (t == 512) { arow = PADF; brow = NQKV; } else { arow = XR0 + 16 * (t - 513); brow = NQKV; }
                        const int l = tid >> 2, tok = 4 * (l >> 4) + (tid & 3), col = l & 15;
                        sum *= pg8::rstd_of(SS1, arow + tok, RMS_EPS);
                        if (t < 512) PROJ[(size_t)(brow >> 7) * CH + (size_t)(arow + tok) * HD + (brow & 127) + col] = (bf16)f2bf(sum);
                        else LOGIT[(size_t)(arow + tok) * 16 + col] = sum; } }
            }
            __syncthreads();
            for (int i = blockIdx.x * 512 + tid; i < 64 * 48 * 16; i += F.G * 512) { const int kc = i / (48 * 16), r = i - kc * (48 * 16), chunk = kc < 32 ? 16 + kc : 32 + kc;
                *(GAS v4u*)(PROJ + (size_t)chunk * CH + (size_t)192 * HD + r * 8) = (v4u){0u, 0u, 0u, 0u}; }
        }
        if (BOTH(4)) GRID_BAR();
    }
    if (IN(5)) {
        const int tid = hidden_tid(), lane = tid & 63; (void)tid; (void)lane;
        const int b = blockIdx.x;
        const float NEGINF = -__builtin_inff();
        if (b < 16) {
            LAS double* ds = (LAS double*)(F.lds + RING_OFF);
            const float bf = args.in[8][b];
            float val[17]; double loc = 0.0;
            const int r0 = PADF + 17 * tid;
#pragma unroll
            for (int i = 0; i < 17; ++i) { const int r = r0 + i; float v = 0.f;
                if (r < MP) { const float xl = LOGIT[(size_t)r * 16 + b] + bf; v = fminf(xl, 0.f) - log1pf(expf(-fabsf(xl))); }
                val[i] = v; loc += (double)v; }
            ds[tid] = loc; __syncthreads();
#pragma unroll 1
            for (int o = 1; o < 512; o <<= 1) { double t = 0.0; if (tid >= o) t = ds[tid - o]; __syncthreads(); ds[tid] += t; __syncthreads(); }
            double run = tid > 0 ? ds[tid - 1] : 0.0;
            float* dst = BIAS + (size_t)(8 + b) * MP;
#pragma unroll
            for (int i = 0; i < 17; ++i) { const int r = r0 + i; run += (double)val[i]; if (r < MP) dst[r] = (float)(-run * (double)INV_SCALE); }
            for (int r = tid; r < PADF; r += 512) dst[r] = NEGINF;
            __syncthreads();
        } else if (b < 24) {
            const int h = b - 16; const float slope = exp2f(-(float)(h + 1));
            float* dst = BIAS + (size_t)h * MP;
            for (int r = tid; r < MP; r += 512) dst[r] = r < PADF ? NEGINF : slope * (float)r * INV_SCALE;
        }
        {
            const size_t CH = (size_t)MP * HD;
            for (int it = (int)blockIdx.x - 24; it >= 0 && it < 64 * 33; it += F.G - 24) {
                const int ci = it / 33, rt = it - ci * 33, chunk = ci < 32 ? ci : ci + 16;
                const bool isq = ci < 16 || (ci >= 32 && ci < 48);
                const int row = rt * 256 + (tid >> 1);
                float ss = 0.f;
                if (row >= (isq ? XR0 : PADF)) { const GAS v4u* p = (const GAS v4u*)(PROJ + (size_t)chunk * CH + (size_t)row * HD + (tid & 1) * 64);
#pragma unroll
                    for (int j = 0; j < 8; ++j) { const v4u w = p[j]; const float a0 = bf_lo(w.x), a1 = bf_hi(w.x), a2 = bf_lo(w.y), a3 = bf_hi(w.y), a4 = bf_lo(w.z), a5 = bf_hi(w.z), a6 = bf_lo(w.w), a7 = bf_hi(w.w);
                        ss += ((a0 * a0 + a1 * a1) + (a2 * a2 + a3 * a3)) + ((a4 * a4 + a5 * a5) + (a6 * a6 + a7 * a7)); } }
                ss += __shfl_xor(ss, 1);
#pragma unroll
                for (int o = 2; o < 64; o <<= 1) ss = fmaxf(ss, __shfl_xor(ss, o));
                if (lane == 0) __hip_atomic_fetch_max((unsigned*)(F.ctl + CW_NORM + chunk), __builtin_bit_cast(unsigned, ss), RLX_AGENT);
            }
        }
        if (BOTH(5)) GRID_BAR();
    }
    if (IN(6)) {
        const int tid = hidden_tid(), lane = tid & 63; (void)lane;
        char* al = (char*)lds + RING_OFF;
        const size_t CH = (size_t)MP * HD;
        volatile LAS int* MQ = (volatile LAS int*)(F.lds + MISC_OFF) + 16;
        const int home = blockIdx.x & 7;
#define QLEN(q_) ((4 + ((q_) < 4 ? 1 : 3)) * 32)
#define ATT_POP(dst_) do { int code_ = -1;                                                                                                 \
            for (int k_ = 0; k_ < 8; ++k_) { const int q_ = (home + k_) & 7;                                                               \
                const unsigned idx_ = __hip_atomic_fetch_add((unsigned*)(F.ctl + CW_QUEUE + 64 * q_), 1u, RLX_AGENT);                      \
                if (idx_ < (unsigned)QLEN(q_)) { code_ = q_ * 256 + (int)idx_; break; } }                                                  \
            dst_ = code_; } while (0)
#define ATT_REF(R_, code_) do { const int q_ = (code_) >> 8, i_ = (code_) & 255; int vh_, qb_;                                              \
            if (i_ < 128) { const int ii_ = i_ & 63, h_ = (i_ < 64) ? 4 + (q_ >> 1) : 3 - (q_ >> 1); vh_ = 4 * h_ + 2 * (q_ & 1) + (ii_ & 1); qb_ = 32 - (ii_ >> 1); } \
            else { const int ii_ = i_ - 128, nf_ = q_ < 4 ? 1 : 3, f_ = ii_ % nf_; qb_ = 32 - ii_ / nf_; vh_ = 32 + (q_ < 4 ? q_ : 4 + 3 * (q_ - 4) + f_); }  \
            int qc_, kc_, vc_, bi_; att::bf16* ob_;                                                                                         \
            if (vh_ < 32) { const int h_ = vh_ >> 2, c_ = (vh_ >> 1) & 1, hf_ = vh_ & 1; qc_ = 2 * h_ + c_; kc_ = 16 + 2 * h_ + c_; vc_ = 32 + 2 * h_ + hf_; bi_ = h_; \
                            ob_ = (c_ ? O1B : OB) + h_ * 256 + hf_ * 128; }                                                                \
            else { const int h_ = vh_ - 32; qc_ = 48 + h_; kc_ = 64 + h_; vc_ = 80 + h_; bi_ = 8 + h_; ob_ = OB + 2048 + h_ * 128; }        \
            R_.Q = PROJ + (size_t)qc_ * CH + (size_t)qb_ * 256 * HD; R_.K = PROJ + (size_t)kc_ * CH; R_.V = PROJ + (size_t)vc_ * CH;        \
            R_.O = ob_ + (size_t)qb_ * 256 * DM; R_.P0 = qb_ * 256;                                                                         \
            const float* bt_ = BIAS + (size_t)bi_ * MP;                                                                                     \
            const float qn_ = __builtin_bit_cast(float, __hip_atomic_load((unsigned*)(F.ctl + CW_NORM + qc_), RLX_AGENT));                   \
            const float kn_ = __builtin_bit_cast(float, __hip_atomic_load((unsigned*)(F.ctl + CW_NORM + kc_), RLX_AGENT));                   \
            const float c0_ = 2.0f * sqrtf(qn_ * kn_) * 1.002f - bt_[R_.P0];                                                               \
            const int ln_ = hidden_tid() & 63, j1_ = 3 + ln_, j2_ = 67 + ln_, je_ = 4 * qb_;                                                                       \
            const bool ns1_ = j1_ < je_ ? !((c0_ + bt_[64 * j1_ + 63]) * (att::SCALE * 1.4426950408889634f) < -160.0f) : true;              \
            const bool ns2_ = j2_ < je_ ? !((c0_ + bt_[64 * j2_ + 63]) * (att::SCALE * 1.4426950408889634f) < -160.0f) : true;              \
            const unsigned long long m1_ = __ballot(ns1_), m2_ = __ballot(ns2_);                                                            \
            int jl_ = m1_ ? 3 + __builtin_ctzll(m1_) : (m2_ ? 67 + __builtin_ctzll(m2_) : je_); if (jl_ > je_) jl_ = je_;                  \
            R_.jlo = __builtin_amdgcn_readfirstlane(jl_); R_##_bias = bt_; } while (0)
#define ATT_BIAS(R_) do { for (int i_ = 16 * R_.jlo + tid; i_ < (R_.P0 + 256) / 4; i_ += 512) *(f32x4*)(al + att::BIAS_OFF + 16 * i_) = *(const f32x4*)(R_##_bias + 4 * i_); } while (0)
        if (tid == 0) { int c0, c1; ATT_POP(c0); if (c0 >= 0) ATT_POP(c1); else c1 = -1; MQ[0] = c0; MQ[2] = c1; }
        __syncthreads();
        const int c_first = MQ[0]; int c_nxt = MQ[2];
        if (c_first >= 0) {
            att::Seam S; att::BlockRef cur, nxt; const float* cur_bias; const float* nxt_bias;
            ATT_REF(cur, c_first);
            ATT_BIAS(cur);
            att::attn_prime(cur, al, S);
            for (;;) {
                const bool last = c_nxt < 0;
                if (!last) ATT_REF(nxt, c_nxt); else { nxt = cur; nxt_bias = cur_bias; }
                if (tid == 0) { int c2 = -1; if (!last) ATT_POP(c2); MQ[0] = c2; }
                att::attn_block(cur, nxt, al, S);
                if (last) break;
                cur = nxt; cur_bias = nxt_bias; c_nxt = MQ[0];
                ATT_BIAS(cur); __syncthreads();
            }
        }
#undef QLEN
#undef ATT_POP
#undef ATT_REF
#undef ATT_BIAS
        if (BOTH(6)) GRID_BAR();
    }
    if (IN(7)) {
        const int tid = hidden_tid(), lane = tid & 63; (void)tid; (void)lane;
        float lam;
        { const float* q1 = args.in[9]; const float* k1 = args.in[10]; const float* q2 = args.in[11]; const float* k2 = args.in[12];
          const float s1 = wave_sum(q1[lane] * k1[lane] + q1[lane + 64] * k1[lane + 64]);
          const float s2 = wave_sum(q2[lane] * k2[lane] + q2[lane + 64] * k2[lane + 64]);
          lam = expf(s1) - expf(s2) + LAMBDA_INIT; }
        const f32x4 gn = *(const f32x4*)(args.in[13] + 4 * lane);
        for (int m = XR0 + gw; m < MP; m += NGW) {
            GAS v2u* o0 = (GAS v2u*)(OB + (size_t)m * DM) + lane; const GAS v2u* o1 = (const GAS v2u*)(O1B + (size_t)m * DM) + lane;
            v2u a[8], c[8];
#pragma unroll
            for (int h = 0; h < 8; ++h) { a[h] = o0[64 * h]; c[h] = o1[64 * h]; }
#pragma unroll
            for (int h = 0; h < 8; ++h) {
                const float x0 = bf_lo(a[h].x) - lam * bf_lo(c[h].x), x1 = bf_hi(a[h].x) - lam * bf_hi(c[h].x), x2 = bf_lo(a[h].y) - lam * bf_lo(c[h].y), x3 = bf_hi(a[h].y) - lam * bf_hi(c[h].y);
                const float ss = wave_sum((x0 * x0 + x1 * x1) + (x2 * x2 + x3 * x3));
                const float r = 1.0f / sqrtf(ss * (1.0f / 256.0f) + SUBLN_EPS);
                v2u w; w.x = pk2(x0 * r * gn.x * (1.0f - LAMBDA_INIT), x1 * r * gn.y * (1.0f - LAMBDA_INIT)); w.y = pk2(x2 * r * gn.z * (1.0f - LAMBDA_INIT), x3 * r * gn.w * (1.0f - LAMBDA_INIT));
                o0[64 * h] = w; }
        }
        if (BOTH(7)) GRID_BAR();
    }
    if (IN(8)) {
        pg8::Gemm g{OB + (size_t)XR0 * DM, WOUT, SEQ, DM, DM}; pg8::StaticOrder S; S.init(SEQ, DM, F.G, (int)blockIdx.x);
        pg8::EpiResid<true> E{H, 0, H, DM, 1.0f, XR0, XN, SS2};
        pg8::gemm_phase<pg8::EpiResid<true>, pg8::StaticOrder, true, true>(F.lds + RING_OFF, g, S, E);
        if (BOTH(8)) GRID_BAR();
    }
    if (IN(10)) {
        pg8::Gemm g{XN + (size_t)XR0 * DM, W2GU, SEQ, NGU, DM}; pg8::StaticOrder S; S.init(SEQ, NGU, F.G, (int)blockIdx.x);
        pg8::EpiSwiGLU E{ACT, DFF, XR0, SS2};
        pg8::gemm_phase<pg8::EpiSwiGLU, pg8::StaticOrder, true, true>(F.lds + RING_OFF, g, S, E);
        { const int tid = hidden_tid(), lane = tid & 63; (void)tid;
          CONV_STREAM(CW_CONVQ2, NITEMS - I_D, I_D); }
        if (BOTH(10)) GRID_BAR();
    }
    if (IN(11)) {
        pg8::Gemm g{ACT + (size_t)XR0 * DFF, W2D, SEQ, DM, DFF}; pg8::StaticOrder S; S.init(SEQ, DM, F.G, (int)blockIdx.x);
        pg8::EpiResid<false> E{H, 0, H, DM, 0.5f, XR0, nullptr, nullptr};
        pg8::gemm_phase<pg8::EpiResid<false>, pg8::StaticOrder, true, true>(F.lds + RING_OFF, g, S, E);
        if (BOTH(11)) GRID_BAR();
    }
    if (IN(12)) {
        const int tid = hidden_tid(), lane = tid & 63; (void)tid;
        const GAS f32x4* gr = (const GAS f32x4*)args.in[19] + lane;
        f32x4 gg[16];
#pragma unroll
        for (int j = 0; j < 16; ++j) gg[j] = gr[64 * j];
#define P12_LOAD(V_, m_) do { const GAS f32x4* xr_ = (const GAS f32x4*)(H + (size_t)(m_) * DM) + lane; _Pragma("unroll") for (int j = 0; j < 16; ++j) V_[j] = __builtin_nontemporal_load(xr_ + 64 * j); } while (0)
#define P12_STORE(V_, m_) do { float s_ = 0.f; _Pragma("unroll") for (int j = 0; j < 16; ++j) s_ += (V_[j].x * V_[j].x + V_[j].y * V_[j].y) + (V_[j].z * V_[j].z + V_[j].w * V_[j].w);   \
            const float r_ = 1.0f / sqrtf(wave_sum(s_) * (1.0f / DM) + RMS_EPS); GAS f32x4* o_ = (GAS f32x4*)(args.out + (size_t)((m_) - XR0) * DM) + lane;                      \
            _Pragma("unroll") for (int j = 0; j < 16; ++j) { f32x4 w_; w_.x = V_[j].x * r_ * gg[j].x; w_.y = V_[j].y * r_ * gg[j].y; w_.z = V_[j].z * r_ * gg[j].z; w_.w = V_[j].w * r_ * gg[j].w; \
                __builtin_nontemporal_store(w_, o_ + 64 * j); } } while (0)
        f32x4 va[16], vb[16];
        int m = XR0 + gw;
        if (m < MP) {
            P12_LOAD(va, m);
            for (;;) {
                const int mn = m + NGW;
                if (mn < MP) P12_LOAD(vb, mn);
                P12_STORE(va, m);
                if (mn >= MP) break;
                const int m2 = mn + NGW;
                if (m2 < MP) P12_LOAD(va, m2);
                P12_STORE(vb, mn);
                if (m2 >= MP) break;
                m = m2;
            }
        }
#undef P12_LOAD
#undef P12_STORE
    }
#undef IN
#undef BOTH
#undef GRID_BAR
}

extern "C" void kernel_launch(void* const* d_in, const int* in_sizes, int n_in, void* d_out, int out_size, void* d_ws, size_t ws_size, hipStream_t stream) {
    static int grid = 0;
    if (grid == 0) {
        if (n_in != 20 || in_sizes[0] != SEQ * DM || out_size != SEQ * DM || ws_size < WS_END) { fprintf(stderr, "kernel_launch: shape / workspace mismatch: n_in %d in0 %d out %d ws %zu (need %zu)\n", n_in, n_in > 0 ? in_sizes[0] : -1, out_size, ws_size, (size_t)WS_END); grid = -1; return; }
        int dev = 0, cus = 0, per_cu = 0;
        if (hipGetDevice(&dev) != hipSuccess || hipDeviceGetAttribute(&cus, hipDeviceAttributeMultiprocessorCount, dev) != hipSuccess) { grid = -1; return; }
        if (hipFuncSetAttribute((const void*)hymba_fwd, hipFuncAttributeMaxDynamicSharedMemorySize, LDS_BYTES) != hipSuccess) { fprintf(stderr, "kernel_launch: hipFuncSetAttribute failed\n"); grid = -1; return; }
        if (hipOccupancyMaxActiveBlocksPerMultiprocessor(&per_cu, (const void*)hymba_fwd, NWAVES * 64, LDS_BYTES) != hipSuccess || per_cu < 1) { fprintf(stderr, "kernel_launch: occupancy query reports %d\n", per_cu); }
        (void)hipGetLastError();
        grid = cus;
        if (grid * 5 < 513 + SEQ / 16 || grid % 8 != 0) { fprintf(stderr, "kernel_launch: built for a 256-CU device (grid %d)\n", grid); grid = -1; return; }
    }
    if (grid < 0) return;
    if (hipMemsetAsync((char*)d_ws + WS_CTL, 0, CTL_ZERO_BYTES, stream) != hipSuccess) return;
    Args a{};
    for (int i = 0; i < 20; ++i) a.in[i] = (const float*)d_in[i];
    a.out = (float*)d_out; a.ws = (unsigned char*)d_ws;
#if defined(PROBE_PHASE)
    a.ph_lo = 0; a.ph_hi = PROBE_PHASE + 1; hipLaunchKernelGGL(hymba_fwd, dim3(grid), dim3(NWAVES * 64), LDS_BYTES, stream, a);
    if (hipMemsetAsync((char*)d_ws + WS_CTL + CW_BAR * 4, 0, (CW_QUEUE + 8 * 64 - CW_BAR) * 4, stream) != hipSuccess) return;
    a.ph_lo = PROBE_PHASE; a.ph_hi = N_PHASES; hipLaunchKernelGGL(hymba_fwd, dim3(grid), dim3(NWAVES * 64), LDS_BYTES, stream, a);
#else
    if (N_LAUNCHES == 1) { a.ph_lo = 0; a.ph_hi = N_PHASES; hipLaunchKernelGGL(hymba_fwd, dim3(grid), dim3(NWAVES * 64), LDS_BYTES, stream, a); }
    else for (int p = 0; p < N_PHASES; ++p) { a.ph_lo = p; a.ph_hi = p + 1; hipLaunchKernelGGL(hymba_fwd, dim3(grid), dim3(NWAVES * 64), LDS_BYTES, stream, a); }
#endif
}
```
